# Optimizing an MI355X kernel written in HIP

```python
import math
import jax, jax.numpy as jnp
from jax import lax
import numpy as np

D_MODEL = 1024
BATCH = 2
SEQ = 8192
DEPTH = 4

GRID_W = 64
CTX_LEN = 256
HEAD_DIM = 64
D_MIX = D_MODEL
LRU_WIDTH = D_MIX // 4
LRU_BLOCKS = 4
LRU_BLOCK = LRU_WIDTH // LRU_BLOCKS
LRU_CONV = 4
LRU_C = 8.0
DIFF_WIDTH = D_MIX // 2
DIFF_VDIM = 2 * HEAD_DIM
DIFF_HEADS = DIFF_WIDTH // DIFF_VDIM
DIFF_QK = DIFF_HEADS * 2 * HEAD_DIM
Q_BLOCK = 128
NA_WIDTH = D_MIX - LRU_WIDTH - DIFF_WIDTH
NA_HEADS = NA_WIDTH // HEAD_DIM
NA_KH_MAX = 8
NA_KW = 16
IN_SECTIONS = (LRU_WIDTH, LRU_WIDTH, DIFF_QK, DIFF_QK, DIFF_WIDTH, NA_WIDTH, NA_WIDTH, NA_WIDTH)
IN_COLS = 2 * LRU_WIDTH + 2 * DIFF_QK + DIFF_WIDTH + 3 * NA_WIDTH
FFN_HIDDEN = -(-8 * D_MODEL // (3 * 256)) * 256
ROPE_BASE = 10000.0
NORM_EPS = 1e-6
NEG_INF = -1e30

kernel_name = 'hybrid_rglru_diffattn_natten_dit'


def _rmsnorm(x, g):
    xf = x.astype(jnp.float32)
    y = xf * lax.rsqrt(jnp.mean(xf * xf, axis=-1, keepdims=True) + NORM_EPS)
    return (y * g.astype(jnp.float32)).astype(x.dtype)


def _modulate(h, shift, scale):
    return h * (1 + scale[:, None, :]) + shift[:, None, :]


def _split_in(p):
    idx = []
    acc = 0
    for w in IN_SECTIONS[:-1]:
        acc += w
        idx.append(acc)
    return jnp.split(p, idx, axis=-1)


def _axial_rope_tables(n, dtype):
    t = jnp.arange(n, dtype=jnp.int32)
    row = (t // GRID_W).astype(jnp.float32)
    col = (t % GRID_W).astype(jnp.float32)
    axis_dim = HEAD_DIM // 2
    inv_freq = 1.0 / (ROPE_BASE ** (jnp.arange(0, axis_dim, 2, dtype=jnp.float32) / axis_dim))
    ang_r = row[:, None] * inv_freq[None]
    ang_c = col[:, None] * inv_freq[None]
    return (jnp.cos(ang_r).astype(dtype), jnp.sin(ang_r).astype(dtype),
            jnp.cos(ang_c).astype(dtype), jnp.sin(ang_c).astype(dtype))


def _rot(x, cos, sin):
    h = x.shape[-1] // 2
    x1, x2 = x[..., :h], x[..., h:]
    return jnp.concatenate([x1 * cos - x2 * sin, x2 * cos + x1 * sin], axis=-1)


def _apply_axial_rope(x, rope):
    cr, sr, cc, sc = rope
    shp = (1, cr.shape[0], 1, 1, cr.shape[1])
    half = HEAD_DIM // 2
    xr = _rot(x[..., :half], cr.reshape(shp), sr.reshape(shp))
    xc = _rot(x[..., half:], cc.reshape(shp), sc.reshape(shp))
    return jnp.concatenate([xr, xc], axis=-1)


def _dwconv_centred(x, w, b):
    L = x.shape[1]
    left = LRU_CONV // 2
    xp = jnp.pad(x, ((0, 0), (left, LRU_CONV - 1 - left), (0, 0)))
    y = b
    for j in range(LRU_CONV):
        y = y + w[j] * xp[:, j:j + L]
    return y


def _rglru_coeffs(xc, wa, ba, wx, bx, lam):
    B_, L, C = xc.shape
    xb = xc.reshape(B_, L, LRU_BLOCKS, LRU_BLOCK)
    r = jax.nn.sigmoid((jnp.einsum('blni,nij->blnj', xb, wa).reshape(B_, L, C) + ba).astype(jnp.float32))
    i = jax.nn.sigmoid((jnp.einsum('blni,nij->blnj', xb, wx).reshape(B_, L, C) + bx).astype(jnp.float32))
    log_a = LRU_C * r * jax.nn.log_sigmoid(lam.astype(jnp.float32))
    a = jnp.exp(log_a)
    b = jnp.sqrt(-jnp.expm1(2.0 * log_a)) * (i * xc.astype(jnp.float32))
    return a, b


def _linear_scan(a, b, h0):
    b = b.at[:, 0].add(a[:, 0] * h0)

    def comb(x, y):
        return (x[0] * y[0], y[0] * x[1] + y[1])

    return lax.associative_scan(comb, (a, b), axis=1)[1]


def _bidir_rglru(xl, xc, wa, ba, wx, bx, lam, want_ctx):
    zeros = jnp.zeros((xc.shape[0], xc.shape[2]), jnp.float32)
    a, b = _rglru_coeffs(xc, wa[0], ba[0], wx[0], bx[0], lam[0])
    hc_f = _linear_scan(a, b, zeros)
    a, b = _rglru_coeffs(xl, wa[0], ba[0], wx[0], bx[0], lam[0])
    hl_f = _linear_scan(a, b, hc_f[:, -1])
    a, b = _rglru_coeffs(xc, wa[1], ba[1], wx[1], bx[1], lam[1])
    hc_b = jnp.flip(_linear_scan(jnp.flip(a, 1), jnp.flip(b, 1), zeros), 1)
    a, b = _rglru_coeffs(xl, wa[1], ba[1], wx[1], bx[1], lam[1])
    hl_b = jnp.flip(_linear_scan(jnp.flip(a, 1), jnp.flip(b, 1), hc_b[:, 0]), 1)
    y_ctx = (hc_f + hc_b) if want_ctx else None
    return hl_f + hl_b, y_ctx


def _diff_attend(q, keys, vals, lam):
    s = jnp.einsum('bqhcd,bkhcd->bhcqk', q, keys, preferred_element_type=jnp.float32) * (HEAD_DIM ** -0.5)
    p = jax.nn.softmax(s, axis=-1)
    w = p[:, :, 0] - lam * p[:, :, 1]
    return jnp.einsum('bhqk,bkhe->bqhe', w.astype(vals.dtype), vals)


def _plain_attend(q, k, v):
    s = jnp.einsum('bqhd,bkhd->bhqk', q, k, preferred_element_type=jnp.float32) * (q.shape[-1] ** -0.5)
    p = jax.nn.softmax(s, axis=-1).astype(v.dtype)
    return jnp.einsum('bhqk,bkhd->bqhd', p, v)


def _na_latent(q, k, v, kc, vc, rpb):
    B_, S, H, d = q.shape
    rows = S // GRID_W
    kh = min(NA_KH_MAX, rows)
    qg = q.reshape(B_, rows, GRID_W, H, d)
    kg = k.reshape(B_, rows, GRID_W, H, d)
    vg = v.reshape(B_, rows, GRID_W, H, d)
    r = jnp.arange(rows)
    r0 = jnp.clip(r - kh // 2, 0, rows - kh)
    row_idx = r0[:, None] + jnp.arange(kh)[None]
    k_strip = kg[:, row_idx]
    v_strip = vg[:, row_idx]
    cq = jnp.arange(GRID_W)
    c0 = jnp.clip(cq - NA_KW // 2, 0, GRID_W - NA_KW)
    in_win = (cq[None] >= c0[:, None]) & (cq[None] < c0[:, None] + NA_KW)
    roff = row_idx - r[:, None] + (NA_KH_MAX - 1)
    coff = jnp.clip(cq[None] - cq[:, None] + (NA_KW - 1), 0, 2 * NA_KW - 2)
    bias = rpb[:, roff[:, None, :, None], coff[None, :, None, :]].astype(jnp.float32)
    bias = jnp.where(in_win[None, None, :, None, :], bias, NEG_INF)
    scale = d ** -0.5
    s_loc = jnp.einsum('brqhd,brkwhd->bhrqkw', qg, k_strip, preferred_element_type=jnp.float32) * scale + bias[None]
    n_loc = kh * GRID_W
    s_loc = s_loc.reshape(B_, H, rows, GRID_W, n_loc)
    s_ctx = jnp.einsum('brqhd,bchd->bhrqc', qg, kc, preferred_element_type=jnp.float32) * scale
    p = jax.nn.softmax(jnp.concatenate([s_loc, s_ctx], axis=-1), axis=-1).astype(v.dtype)
    p_loc = p[..., :n_loc].reshape(B_, H, rows, GRID_W, kh, GRID_W)
    out = (jnp.einsum('bhrqkw,brkwhd->brqhd', p_loc, v_strip)
           + jnp.einsum('bhrqc,bchd->brqhd', p[..., n_loc:], vc))
    return out.reshape(B_, S, H * d)


def _mixer(px, pc, lam_init, want_ctx, rope, conv_w, conv_b, wa, ba, wx, bx, lru_lam, diff_lam, subln_g, rpb):
    B_, S, _ = px.shape
    Bc, C, _ = pc.shape
    xl, gl, qd, kd, vd, qn, kn, vn = _split_in(px)
    cxl, cgl, cqd, ckd, cvd, cqn, ckn, cvn = _split_in(pc)
    y_lat, y_ctx = _bidir_rglru(_dwconv_centred(xl, conv_w, conv_b), _dwconv_centred(cxl, conv_w, conv_b),
                                wa, ba, wx, bx, lru_lam, want_ctx)
    lru_x = y_lat.astype(px.dtype) * jax.nn.gelu(gl)
    dl = diff_lam.astype(jnp.float32)
    lam = jnp.exp(jnp.sum(dl[0] * dl[1])) - jnp.exp(jnp.sum(dl[2] * dl[3])) + lam_init
    qd = _apply_axial_rope(qd.reshape(B_, S, DIFF_HEADS, 2, HEAD_DIM), rope)
    kd = _apply_axial_rope(kd.reshape(B_, S, DIFF_HEADS, 2, HEAD_DIM), rope)
    vd = vd.reshape(B_, S, DIFF_HEADS, DIFF_VDIM)
    ckd = ckd.reshape(Bc, C, DIFF_HEADS, 2, HEAD_DIM)
    cvd = cvd.reshape(Bc, C, DIFF_HEADS, DIFF_VDIM)
    keys = jnp.concatenate([ckd, kd], axis=1)
    vals = jnp.concatenate([cvd, vd], axis=1)
    nb = S // Q_BLOCK
    qblocks = jnp.moveaxis(qd.reshape(B_, nb, Q_BLOCK, DIFF_HEADS, 2, HEAD_DIM), 1, 0)
    od = lax.map(lambda qb: _diff_attend(qb, keys, vals, lam), qblocks)
    od = jnp.moveaxis(od, 0, 1).reshape(B_, S, DIFF_HEADS, DIFF_VDIM)
    diff_x = (_rmsnorm(od, subln_g) * (1.0 - lam_init)).reshape(B_, S, DIFF_WIDTH)
    ckn = ckn.reshape(Bc, C, NA_HEADS, HEAD_DIM)
    cvn = cvn.reshape(Bc, C, NA_HEADS, HEAD_DIM)
    na_x = _na_latent(qn.reshape(B_, S, NA_HEADS, HEAD_DIM), kn.reshape(B_, S, NA_HEADS, HEAD_DIM),
                      vn.reshape(B_, S, NA_HEADS, HEAD_DIM), ckn, cvn, rpb)
    mix_x = jnp.concatenate([lru_x, diff_x, na_x], axis=-1)
    if not want_ctx:
        return mix_x, None
    lru_c = y_ctx.astype(pc.dtype) * jax.nn.gelu(cgl)
    od_c = _diff_attend(cqd.reshape(Bc, C, DIFF_HEADS, 2, HEAD_DIM), ckd, cvd, lam)
    diff_c = (_rmsnorm(od_c, subln_g) * (1.0 - lam_init)).reshape(Bc, C, DIFF_WIDTH)
    na_c = _plain_attend(cqn.reshape(Bc, C, NA_HEADS, HEAD_DIM), ckn, cvn).reshape(Bc, C, NA_WIDTH)
    mix_c = jnp.concatenate([lru_c, diff_c, na_c], axis=-1)
    return mix_x, mix_c


def _swiglu(h, w_gu, w_down):
    g, u = jnp.split(h @ w_gu, 2, axis=-1)
    return (jax.nn.silu(g) * u) @ w_down


def setup_inputs(seed: int = 0) -> dict:
    key = jax.random.key(seed)
    ks = jax.random.split(key, 24)
    f32 = jnp.float32
    D = D_MODEL

    def nrm(k, shape, scale):
        return jax.random.normal(k, shape, f32) * scale

    u = jax.random.uniform(ks[15], (DEPTH, 2, LRU_WIDTH), f32, 0.9, 0.999)
    sa = u ** (1.0 / LRU_C)
    return {
        'x': nrm(ks[0], (BATCH, SEQ, D), 1.0),
        'c': nrm(ks[1], (BATCH, D), 1.0),
        'ctx': nrm(ks[2], (BATCH, CTX_LEN, D), 1.0),
        'c_ctx': nrm(ks[3], (D,), 1.0),
        'w_mod': nrm(ks[4], (DEPTH, D, 6 * D), 0.5 * D ** -0.5),
        'b_mod': nrm(ks[5], (DEPTH, 6 * D), 0.01),
        'norm1_g': 1.0 + nrm(ks[6], (DEPTH, D), 0.02),
        'norm2_g': 1.0 + nrm(ks[7], (DEPTH, D), 0.02),
        'w_in': nrm(ks[8], (DEPTH, D, IN_COLS), D ** -0.5),
        'lru_conv_w': nrm(ks[9], (DEPTH, LRU_CONV, LRU_WIDTH), LRU_CONV ** -0.5),
        'lru_conv_b': nrm(ks[10], (DEPTH, LRU_WIDTH), 0.01),
        'lru_wa': nrm(ks[11], (DEPTH, 2, LRU_BLOCKS, LRU_BLOCK, LRU_BLOCK), LRU_BLOCK ** -0.5),
        'lru_ba': nrm(ks[12], (DEPTH, 2, LRU_WIDTH), 0.01),
        'lru_wx': nrm(ks[13], (DEPTH, 2, LRU_BLOCKS, LRU_BLOCK, LRU_BLOCK), LRU_BLOCK ** -0.5),
        'lru_bx': nrm(ks[14], (DEPTH, 2, LRU_WIDTH), 0.01),
        'lru_lambda': jnp.log(sa) - jnp.log1p(-sa),
        'diff_lambda': nrm(ks[16], (DEPTH, 4, HEAD_DIM), 0.1),
        'diff_subln_g': 1.0 + nrm(ks[17], (DEPTH, DIFF_VDIM), 0.02),
        'na_rpb': nrm(ks[18], (DEPTH, NA_HEADS, 2 * NA_KH_MAX - 1, 2 * NA_KW - 1), 0.1),
        'w_out': nrm(ks[19], (DEPTH, D_MIX, D), D_MIX ** -0.5),
        'ffn_w_gu': nrm(ks[20], (DEPTH, D, 2 * FFN_HIDDEN), D ** -0.5),
        'ffn_w_down': nrm(ks[21], (DEPTH, FFN_HIDDEN, D), FFN_HIDDEN ** -0.5),
        'final_g': 1.0 + nrm(ks[22], (D,), 0.02),
    }


def reference(x, c, ctx, c_ctx, w_mod, b_mod, norm1_g, norm2_g, w_in, lru_conv_w, lru_conv_b,
              lru_wa, lru_ba, lru_wx, lru_bx, lru_lambda, diff_lambda, diff_subln_g, na_rpb,
              w_out, ffn_w_gu, ffn_w_down, final_g):
    S = x.shape[1]
    rope = _axial_rope_tables(S, x.dtype)
    cond_x = jax.nn.silu(c)
    cond_c = jax.nn.silu(c_ctx)[None]
    h_ctx = ctx
    for l in range(DEPTH):
        last = l == DEPTH - 1
        lam_init = 0.8 - 0.6 * math.exp(-0.3 * l)
        mx = jnp.split(cond_x @ w_mod[l] + b_mod[l], 6, axis=-1)
        mc = jnp.split(cond_c @ w_mod[l] + b_mod[l], 6, axis=-1)
        hx = _modulate(_rmsnorm(x, norm1_g[l]), mx[0], mx[1])
        hc = _modulate(_rmsnorm(h_ctx, norm1_g[l]), mc[0], mc[1])
        mix_x, mix_c = _mixer(hx @ w_in[l], hc @ w_in[l], lam_init, not last, rope,
                              lru_conv_w[l], lru_conv_b[l], lru_wa[l], lru_ba[l], lru_wx[l], lru_bx[l],
                              lru_lambda[l], diff_lambda[l], diff_subln_g[l], na_rpb[l])
        x = x + mx[2][:, None, :] * (mix_x @ w_out[l])
        hx2 = _modulate(_rmsnorm(x, norm2_g[l]), mx[3], mx[4])
        x = x + mx[5][:, None, :] * _swiglu(hx2, ffn_w_gu[l], ffn_w_down[l])
        if not last:
            h_ctx = h_ctx + mc[2][:, None, :] * (mix_c @ w_out[l])
            hc2 = _modulate(_rmsnorm(h_ctx, norm2_g[l]), mc[3], mc[4])
            h_ctx = h_ctx + mc[5][:, None, :] * _swiglu(hc2, ffn_w_gu[l], ffn_w_down[l])
    return _rmsnorm(x, final_g)
```

```cpp
#include <hip/hip_runtime.h>
#include <hip/hip_cooperative_groups.h>
#include <cstdio>
#include <cstdint>
namespace cg = cooperative_groups;
#ifndef PROBE_DUP
#define PROBE_DUP 0
#endif

typedef unsigned short bf16_t;
typedef short bf16x8 __attribute__((ext_vector_type(8)));
typedef float f32x4 __attribute__((ext_vector_type(4)));
typedef float f32x16 __attribute__((ext_vector_type(16)));
typedef unsigned u32x4 __attribute__((ext_vector_type(4)));
typedef unsigned u32x2 __attribute__((ext_vector_type(2)));

#define DI __device__ __forceinline__
#define MFMA32(a, b, c) __builtin_amdgcn_mfma_f32_32x32x16_bf16((a), (b), (c), 0, 0, 0)
#define MFMA16(a, b, c) __builtin_amdgcn_mfma_f32_16x16x32_bf16((a), (b), (c), 0, 0, 0)

constexpr int D = 1024, SEQ = 8192, NBATCH = 2, DEPTH = 4, CTXL = 256;
constexpr int TL = NBATCH * SEQ, TC = NBATCH * CTXL, T = TL + TC;
constexpr int INC = 2816, FFH = 2816, NKEY = CTXL + SEQ;
constexpr int LDS_BYTES = 131072 + 16;
constexpr int LDS_CONST = 122880;
constexpr int NT = 512;

struct Params {
  const float *x, *c, *ctx, *c_ctx, *w_mod, *b_mod, *norm1_g, *norm2_g, *w_in, *conv_w, *conv_b, *lru_wa, *lru_ba, *lru_wx, *lru_bx,
      *lru_lam, *diff_lam, *subln_g, *rpb, *w_out, *w_gu, *w_down, *final_g;
  float* out;
  bf16_t *Win_t, *Wout_t, *Wgu_t, *Wdown_t, *Wl;
  float* X;
  bf16_t *H, *P, *MIX, *Vtd, *Vtn;
  float *mods, *rope, *aggS, *aggG;
  unsigned* bar;
};

typedef const __attribute__((address_space(4))) Params* KP;
DI KP get_params() { KP kp = (KP)__builtin_amdgcn_kernarg_segment_ptr(); asm volatile("" : "+s"(kp)); return kp; }

#define XB_TMO      128
#define XB_XCNT(j)  (256  + 64 * (j))
#define XB_XSUB(j)  (1280 + 64 * (j))
#define XB_XGEN(j)  (2304 + 64 * (j))
#define XB_TOP      3328
#define XB_TOPGEN   3392
#define XCD_BAR_WORDS 3456
#define XB_SPIN_CAP (1u << 22)
#define LAS __attribute__((address_space(3)))
DI unsigned xb_ld(unsigned* p)              { return __hip_atomic_load(p, __ATOMIC_RELAXED, __HIP_MEMORY_SCOPE_AGENT); }
DI unsigned xb_add(unsigned* p, unsigned v) { return __hip_atomic_fetch_add(p, v, __ATOMIC_RELAXED, __HIP_MEMORY_SCOPE_AGENT); }
DI unsigned xb_xcc_id() { return (unsigned)__builtin_amdgcn_s_getreg((3 << 11) | 20) & 0xFu; }
#define XB_SPIN(cond, bar) do { unsigned _sp = 0; while (cond) { __builtin_amdgcn_s_sleep(1); \
    if ((++_sp & 255u) == 0u) { if (xb_ld(&(bar)[XB_TMO])) break; if (_sp > XB_SPIN_CAP) { atomicAdd(&(bar)[XB_TMO], 1u); break; } } } } while (0)
struct XcdBarrier { unsigned* bar; unsigned x; volatile LAS unsigned* st; };
DI XcdBarrier xcd_barrier_post(unsigned* bar, volatile LAS unsigned* st) {
  XcdBarrier b; b.bar = bar; b.x = xb_xcc_id(); b.st = st;
  if (threadIdx.x == 0) (void)xb_add(&bar[XB_XCNT(b.x)], 1u);
  return b;
}
DI void xcd_barrier_complete(unsigned* bar, unsigned x, unsigned& nloc, unsigned& nx) {
  const unsigned G = gridDim.x * gridDim.y * gridDim.z;
  unsigned sum, cnt, mine, sp = 0u;
  for (;;) {
    sum = 0u; cnt = 0u; mine = 0u;
#pragma unroll
    for (unsigned j = 0; j < 16; ++j) { const unsigned c = xb_ld(&bar[XB_XCNT(j)]); sum += c; cnt += (c > 0u) ? 1u : 0u; mine = (j == x) ? c : mine; }
    if (sum == G) break;
    __builtin_amdgcn_s_sleep(1);
    if ((++sp & 255u) == 0u) { if (xb_ld(&bar[XB_TMO])) break; if (sp > XB_SPIN_CAP) { atomicAdd(&bar[XB_TMO], 1u); break; } }
  }
  nloc = mine > 0u ? mine : 1u; nx = cnt > 0u ? cnt : 1u;
}
DI void xcd_barrier(const XcdBarrier& b) {
  asm volatile("s_waitcnt vmcnt(0)" ::: "memory");
  __syncthreads();
  if (threadIdx.x == 0) {
    unsigned* bar = b.bar;
    __builtin_amdgcn_s_waitcnt(0);
    unsigned nloc = b.st[0], nx = b.st[1];
    if (nloc == 0u) { xcd_barrier_complete(bar, b.x, nloc, nx); b.st[0] = nloc; b.st[1] = nx; }
    const unsigned old = xb_add(&bar[XB_XSUB(b.x)], 1u);
    const unsigned gen = old / nloc;
    if (old + 1u == (gen + 1u) * nloc) {
      __builtin_amdgcn_fence(__ATOMIC_RELEASE, "agent");
      asm volatile("s_waitcnt vmcnt(0)" ::: "memory");
      const unsigned og = xb_add(&bar[XB_TOP], 1u);
      const unsigned tg = og / nx;
      if (og + 1u == (tg + 1u) * nx) xb_add(&bar[XB_TOPGEN], 1u);
      else XB_SPIN(xb_ld(&bar[XB_TOPGEN]) == tg, bar);
      __builtin_amdgcn_fence(__ATOMIC_ACQUIRE, "agent");
      xb_add(&bar[XB_XGEN(b.x)], 1u);
      asm volatile("s_waitcnt vmcnt(0)" ::: "memory");
    } else {
      XB_SPIN(xb_ld(&bar[XB_XGEN(b.x)]) == gen, bar);
      __builtin_amdgcn_fence(__ATOMIC_ACQUIRE, "agent");
      asm volatile("s_waitcnt vmcnt(0)" ::: "memory");
    }
  }
  __syncthreads();
}

DI int tid_() { int t = threadIdx.x; asm volatile("" : "+v"(t)); return t; }
DI int bid_() { int b = blockIdx.x; asm volatile("" : "+s"(b)); return b; }
DI int gdim_() { int g = gridDim.x; asm volatile("" : "+s"(g)); return g; }

DI unsigned f2bf(float x) { unsigned u = __float_as_uint(x); u += 0x7fffu + ((u >> 16) & 1u); return u >> 16; }
typedef __bf16 bf16v2_t __attribute__((ext_vector_type(2)));
typedef float f32x2 __attribute__((ext_vector_type(2)));
DI unsigned pk2(float lo, float hi) { f32x2 v = {lo, hi}; bf16v2_t b = __builtin_convertvector(v, bf16v2_t); return __builtin_bit_cast(unsigned, b); }
DI float bf2f(bf16_t v) { return __uint_as_float(((unsigned)v) << 16); }
DI float wave_sum(float v) {
#pragma unroll
  for (int o = 1; o < 64; o <<= 1) v += __shfl_xor(v, o);
  return v;
}
DI float xhalf_max(float v) { const auto r = __builtin_amdgcn_permlane32_swap(__float_as_uint(v), __float_as_uint(v), false, false); return fmaxf(__uint_as_float(r[0]), __uint_as_float(r[1])); }
DI float sigmoidf_(float x) { return __builtin_amdgcn_rcpf(1.f + __expf(-x)); }
DI float gelu_tanh(float x) { const float u = 0.7978845608028654f * (x + 0.044715f * x * x * x); return 0.5f * x * (1.f + tanhf(u)); }

DI void wt_unit(const float* W, int K, int N, bf16_t* WT, int kt, int ntile, bool gu, float* scr  ) {
  const int tid = tid_(), k0 = kt * 64, n0 = ntile * 128;
  __syncthreads();
  {
    const int n = tid & 127, kq = tid >> 7;
#pragma unroll 4
    for (int i = 0; i < 16; ++i) { const int k = kq * 16 + i; scr[k * 129 + n] = W[(size_t)(k0 + k) * N + n0 + n]; }
  }
  __syncthreads();
  {
    const int n = tid >> 2, kq = tid & 3;
    const float* s = scr + (kq * 16) * 129 + n;
    u32x4 o0, o1;
    o0.x = pk2(s[0 * 129], s[1 * 129]); o0.y = pk2(s[2 * 129], s[3 * 129]); o0.z = pk2(s[4 * 129], s[5 * 129]); o0.w = pk2(s[6 * 129], s[7 * 129]);
    o1.x = pk2(s[8 * 129], s[9 * 129]); o1.y = pk2(s[10 * 129], s[11 * 129]); o1.z = pk2(s[12 * 129], s[13 * 129]); o1.w = pk2(s[14 * 129], s[15 * 129]);
    const int nsrc = n0 + n;
    int ndst = nsrc;
    if (gu) { const int sel = nsrc < FFH ? 0 : 1; const int j = nsrc - sel * FFH; ndst = (j >> 4) * 32 + sel * 16 + (j & 15); }
    bf16_t* d = WT + (size_t)ndst * K + k0 + kq * 16;
    *(u32x4*)d = o0; *(u32x4*)(d + 8) = o1;
  }
}

DI void mods_unit(KP p, int l, int cb, float* lds) {
  const int tid = tid_();
  float* cond = lds;
  float* red = lds + 3072;
  __syncthreads();
  for (int i = tid; i < 3072; i += NT) { const int v = i >> 10, k = i & 1023; const float c = v < 2 ? p->c[v * 1024 + k] : p->c_ctx[k]; cond[i] = c / (1.f + __expf(-c)); }
  __syncthreads();
  const int c4 = tid & 31, kg = tid >> 5;
  f32x4 a0 = {0.f, 0.f, 0.f, 0.f}, a1 = a0, a2 = a0;
  const float* w = p->w_mod + (size_t)l * 1024 * 6144 + cb * 128 + c4 * 4;
#pragma unroll 8
  for (int k = kg * 64; k < kg * 64 + 64; ++k) { const f32x4 wv = *(const f32x4*)(w + (size_t)k * 6144); a0 += wv * cond[k]; a1 += wv * cond[1024 + k]; a2 += wv * cond[2048 + k]; }
  *(f32x4*)(red + (kg * 3 + 0) * 128 + c4 * 4) = a0; *(f32x4*)(red + (kg * 3 + 1) * 128 + c4 * 4) = a1; *(f32x4*)(red + (kg * 3 + 2) * 128 + c4 * 4) = a2;
  __syncthreads();
  if (tid < 384) {
    const int v = tid >> 7, c2 = tid & 127;
    float s_ = 0.f;
#pragma unroll
    for (int q = 0; q < 16; ++q) s_ += red[(q * 3 + v) * 128 + c2];
    p->mods[(size_t)(l * 3 + v) * 6144 + cb * 128 + c2] = s_ + p->b_mod[l * 6144 + cb * 128 + c2];
  }
}

DI void phase_prologue(KP p, char* ldsc) {
  const int tid = tid_(), nb = gdim_(), bid = bid_();
  float* lds = (float*)ldsc;
  constexpr int U_MODS = DEPTH * 48, U_IN = 16 * 22, U_OUT = 16 * 8, U_GU = 16 * 44, U_DN = 44 * 8, U_WL = U_IN + U_OUT + U_GU + U_DN;
  constexpr int U_TOTAL = U_MODS + DEPTH * U_WL + 64 + 1;
  for (int u = bid; u < U_TOTAL; u += nb) {
    int r = u;
    if (r < U_MODS) { mods_unit(p, r / 48, r % 48, lds); continue; }
    r -= U_MODS;
    if (r < DEPTH * U_WL) {
      const int l = r / U_WL; r -= l * U_WL;
      if (r < U_IN) { wt_unit(p->w_in + (size_t)l * D * INC, D, INC, p->Win_t + (size_t)l * INC * D, r / 22, r % 22, false, lds); continue; }
      r -= U_IN;
      if (r < U_OUT) { wt_unit(p->w_out + (size_t)l * D * D, D, D, p->Wout_t + (size_t)l * D * D, r / 8, r % 8, false, lds); continue; }
      r -= U_OUT;
      if (r < U_GU) { wt_unit(p->w_gu + (size_t)l * D * 2 * FFH, D, 2 * FFH, p->Wgu_t + (size_t)l * 2 * FFH * D, r / 44, r % 44, true, lds); continue; }
      r -= U_GU;
      wt_unit(p->w_down + (size_t)l * FFH * D, FFH, D, p->Wdown_t + (size_t)l * D * FFH, r / 8, r % 8, false, lds);
      continue;
    }
    r -= DEPTH * U_WL;
    if (r < 64) {
      const int l = r >> 4, n = (r >> 2) & 3, dir = (r >> 1) & 1, kind = r & 1;
      const float* src = (kind ? p->lru_wx : p->lru_wa) + (size_t)((l * 2 + dir) * 4 + n) * 4096;
      bf16_t* dst = p->Wl + (size_t)r * 4096;
      for (int e = tid; e < 4096; e += NT) { const int j = e >> 6, i = e & 63; dst[j * 64 + i] = (bf16_t)f2bf(src[i * 64 + j]); }
      continue;
    }
    for (int e = tid; e < 128 * 16; e += NT) {
      const int pos = e >> 4, i = e & 15;
      const float inv = 1.0f / powf(10000.0f, (float)(2 * i) / 32.0f);
      const float ang = (float)pos * inv;
      p->rope[e * 2] = cosf(ang); p->rope[e * 2 + 1] = sinf(ang);
    }
  }
}

DI void phase_norm(KP p, const float* g, const float* mods_l, int shift_idx, int scale_idx, int nrows, const float* xlat, const float* xctx) {
  const int lane = tid_() & 63, gw = bid_() * 8 + (tid_() >> 6), ngw = gdim_() * 8;
  constexpr int R = 3;
#pragma unroll 1
  for (int row0 = gw; row0 < nrows; row0 += R * ngw) {
    f32x4 v[R][4]; float ss[R];
#pragma unroll
    for (int r = 0; r < R; ++r) {
      const int row = min(row0 + r * ngw, nrows - 1);
      const float* xr = row < TL ? xlat + (size_t)row * D : xctx + (size_t)(row - TL) * D;
#pragma unroll
      for (int j = 0; j < 4; ++j) v[r][j] = *(const f32x4*)(xr + j * 256 + lane * 4);
    }
#pragma unroll
    for (int r = 0; r < R; ++r) {
      float s_ = 0.f;
#pragma unroll
      for (int j = 0; j < 4; ++j) s_ += (v[r][j].x * v[r][j].x + v[r][j].y * v[r][j].y) + (v[r][j].z * v[r][j].z + v[r][j].w * v[r][j].w);
      ss[r] = wave_sum(s_);
    }
#pragma unroll
    for (int r = 0; r < R; ++r) {
      const int row = row0 + r * ngw;
      if (row < nrows) {
        const float rstd = 1.0f / sqrtf(ss[r] * (1.0f / D) + 1e-6f);
        const int vs = row < SEQ ? 0 : (row < TL ? 1 : 2);
        const float* sh = mods_l + vs * 6144 + shift_idx * 1024;
        const float* sc = mods_l + vs * 6144 + scale_idx * 1024;
        bf16_t* hr = p->H + (size_t)row * D;
#pragma unroll
        for (int j = 0; j < 4; ++j) {
          const int c = j * 256 + lane * 4;
          const f32x4 gv = *(const f32x4*)(g + c), shv = *(const f32x4*)(sh + c), scv = *(const f32x4*)(sc + c);
          const f32x4 h = v[r][j] * rstd * gv * (scv + 1.0f) + shv;
          u32x2 o; o.x = pk2(h.x, h.y); o.y = pk2(h.z, h.w);
          *(u32x2*)(hr + c) = o;
        }
      }
    }
  }
}

DI void phase_final(KP p) {
  const int lane = tid_() & 63, gw = bid_() * 8 + (tid_() >> 6), ngw = gdim_() * 8;
  constexpr int R = 4;
#pragma unroll 1
  for (int row0 = gw; row0 < TL; row0 += R * ngw) {
    f32x4 v[R][4]; float ss[R];
#pragma unroll
    for (int r = 0; r < R; ++r) {
      const int row = min(row0 + r * ngw, TL - 1);
      const float* xr = p->X + (size_t)row * D;
#pragma unroll
      for (int j = 0; j < 4; ++j) v[r][j] = *(const f32x4*)(xr + j * 256 + lane * 4);
    }
#pragma unroll
    for (int r = 0; r < R; ++r) {
      float s_ = 0.f;
#pragma unroll
      for (int j = 0; j < 4; ++j) s_ += (v[r][j].x * v[r][j].x + v[r][j].y * v[r][j].y) + (v[r][j].z * v[r][j].z + v[r][j].w * v[r][j].w);
      ss[r] = wave_sum(s_);
    }
#pragma unroll
    for (int r = 0; r < R; ++r) {
      const int row = row0 + r * ngw;
      if (row < TL) {
        const float rstd = 1.0f / sqrtf(ss[r] * (1.0f / D) + 1e-6f);
        float* orow = p->out + (size_t)row * D;
#pragma unroll
        for (int j = 0; j < 4; ++j) { const int c = j * 256 + lane * 4; const f32x4 gv = *(const f32x4*)(p->final_g + c); *(f32x4*)(orow + c) = v[r][j] * rstd * gv; }
      }
    }
  }
}

constexpr int BM = 256, BK = 64, HALF = 128, HT = HALF * BK;
DI int lds_byte(int r, int c) { const int st = (r >> 4) * 2 + (c >> 5), rr = r & 15, cc = c & 31, ob = rr * 64 + cc * 2; return st * 1024 + (ob ^ (((ob >> 9) & 1) << 5)); }
DI void stage_rc(int b, int& R, int& C) { const int st = b / 1024, sb = b % 1024, swz = sb ^ (((sb >> 9) & 1) << 5); R = (st >> 1) * 16 + swz / 64; C = (st & 1) * 32 + (swz % 64) / 2; }

struct GemmArgs { const bf16_t* A; const bf16_t* Bt; int M, N, K, mode; bf16_t* Ob; float* X; const float* gate; const float* rope; int ctx; const float* Xlat; const float* Xctx; };

DI void gemm_phase(const GemmArgs& g, char* shm_c) {
  typedef __attribute__((address_space(3))) unsigned char lds_u8;
  lds_u8* lds = (lds_u8*)shm_c;
  const int K = g.K;
  const int tid = tid_(), wid = __builtin_amdgcn_readfirstlane(tid >> 6), lane = tid & 63, wr = wid >> 2, wc = wid & 3, fr = lane & 15, fq = lane >> 4;
  unsigned voff[2];
#pragma unroll
  for (int i = 0; i < 2; ++i) { int R, C; stage_rc(tid * 16 + i * 8192, R, C); voff[i] = (unsigned)(R * K + C) * 2u; }
  const size_t kstep = (size_t)(BK * 2), hstep = (size_t)HALF * K * 2, tstep = 2 * hstep;
  const unsigned ldsw = (unsigned)wid * 1024u;
  const int aoff = lds_byte(wr * 64 + fr, fq * 8), boff = lds_byte(wc * 32 + fr, fq * 8);
#define SA(b, h) (((b) * 2 + (h)) * (HT * 2))
#define SB(b, h) ((4 + (b) * 2 + (h)) * (HT * 2))
#define STAGE(bufoff, gbase) do { _Pragma("unroll") for (int _i = 0; _i < 2; ++_i) \
    __builtin_amdgcn_global_load_lds((const unsigned*)((const char*)(gbase) + voff[_i]), (__attribute__((address_space(3))) unsigned*)(lds + (bufoff) + ldsw + _i * 8192), 16, 0, 0); } while (0)
#define LDA(dst, b, h) do { _Pragma("unroll") for (int m = 0; m < 4; ++m) _Pragma("unroll") for (int k = 0; k < 2; ++k) dst[m][k] = *(const __attribute__((address_space(3))) bf16x8*)(lds + SA(b, h) + aoff + m * 2048 + k * 1024); } while (0)
#define LDB(dst, b, h) do { _Pragma("unroll") for (int n = 0; n < 2; ++n) _Pragma("unroll") for (int k = 0; k < 2; ++k) dst[n][k] = *(const __attribute__((address_space(3))) bf16x8*)(lds + SB(b, h) + boff + n * 2048 + k * 1024); } while (0)
#define MMA(ai, bj, At_, Bt_) do { __builtin_amdgcn_s_setprio(1); \
    _Pragma("unroll") for (int m = 0; m < 4; ++m) _Pragma("unroll") for (int n = 0; n < 2; ++n) _Pragma("unroll") for (int k = 0; k < 2; ++k) \
      acc[ai][bj][m][n] = MFMA16(Bt_[n][k], At_[m][k], acc[ai][bj][m][n]); \
    __builtin_amdgcn_s_setprio(0); } while (0)
#define WAIT_V(n) asm volatile("s_waitcnt vmcnt(" #n ")" ::: "memory")
#define WAIT_L(n) asm volatile("s_waitcnt lgkmcnt(" #n ")" ::: "memory")
#define BAR __builtin_amdgcn_s_barrier()
#define SCHED __builtin_amdgcn_sched_barrier(0)
  const int nM = g.M / BM, nN = g.N / BM, ntiles = nM * nN;
  const int nt = K / BK;
#define TILE_PMPN(tile_, pm_, pn_) do { int wgid = (tile_); const int q = ntiles / 8, rr = ntiles % 8, xcd = wgid % 8, off = wgid / 8; \
    wgid = (xcd < rr ? xcd * (q + 1) : rr * (q + 1) + (xcd - rr) * q) + off; \
    const int nig = 8 * nN, gid = wgid / nig, fm = gid * 8, gsz = (nM - fm) < 8 ? (nM - fm) : 8; \
    pm_ = fm + ((wgid % nig) % gsz); pn_ = (wgid % nig) / gsz; } while (0)
#define PRO_ISSUE(cA_, cB_) do { STAGE(SB(0, 0), cB_); STAGE(SA(0, 0), cA_); STAGE(SB(0, 1), (cB_) + hstep); STAGE(SA(0, 1), (cA_) + hstep); \
    STAGE(SB(1, 0), (cB_) + kstep); STAGE(SA(1, 0), (cA_) + kstep); STAGE(SB(1, 1), (cB_) + hstep + kstep); } while (0)
  const int gstep = gdim_();
  int tile = bid_();
  int pm = 0, pn = 0;
  const char* cA = nullptr; const char* cB = nullptr;
  const bool has_work = tile < ntiles;
  f32x4 acc[2][2][4][2];
  bf16x8 At[4][2], B0[2][2], B1[2][2];
  if (has_work) {
    TILE_PMPN(tile, pm, pn); cA = (const char*)g.A + (size_t)pm * tstep; cB = (const char*)g.Bt + (size_t)pn * tstep;
#pragma unroll
    for (int a = 0; a < 2; ++a)
#pragma unroll
      for (int b = 0; b < 2; ++b)
#pragma unroll
        for (int m = 0; m < 4; ++m)
#pragma unroll
          for (int n = 0; n < 2; ++n) acc[a][b][m][n] = (f32x4){0.f, 0.f, 0.f, 0.f};
    STAGE(SB(0, 0), cB); STAGE(SB(0, 1), cB + hstep); STAGE(SA(0, 0), cA); STAGE(SA(0, 1), cA + hstep);
    if (wr == 1) BAR;
    WAIT_V(2); BAR;
    STAGE(SB(1, 0), cB + kstep); STAGE(SA(1, 0), cA + kstep); STAGE(SB(1, 1), cB + hstep + kstep);
    WAIT_V(6); BAR;
  }
#pragma unroll 1
  while (has_work) {
    const int brow = pm * BM, bcol = pn * BM;
    const int ntile = tile + gstep;
    const bool has_next = ntile < ntiles;
    int npm = pm, npn = pn;
    if (has_next) TILE_PMPN(ntile, npm, npn);
    const char* nA = (const char*)g.A + (size_t)npm * tstep; const char* nB = (const char*)g.Bt + (size_t)npn * tstep;
#pragma unroll 1
    for (int t = 0; t < nt; t += 2) {
      const bool last = t == nt - 2;
      const char* a1 = cA + (size_t)(t + 1) * kstep;
      const char* a2 = last ? nA : cA + (size_t)(t + 2) * kstep; const char* b2 = last ? nB : cB + (size_t)(t + 2) * kstep;
      const char* a3 = a2 + kstep; const char* b3 = b2 + kstep;
      LDB(B0, 0, 0); LDB(B1, 0, 1); SCHED; LDA(At, 0, 0); STAGE(SA(1, 1), a1 + hstep);
      WAIT_V(8); WAIT_L(0); BAR; MMA(0, 0, At, B0); MMA(0, 1, At, B1); BAR; SCHED;
      LDA(At, 0, 1); STAGE(SB(0, 0), b2); STAGE(SB(0, 1), b2 + hstep); STAGE(SA(0, 0), a2);
      WAIT_V(8); WAIT_L(0); BAR; MMA(1, 0, At, B0); MMA(1, 1, At, B1); BAR; SCHED;
      LDB(B0, 1, 0); LDB(B1, 1, 1); SCHED; LDA(At, 1, 0); STAGE(SA(0, 1), a2 + hstep);
      WAIT_V(8); WAIT_L(0); BAR; MMA(0, 0, At, B0); MMA(0, 1, At, B1); BAR; SCHED;
      LDA(At, 1, 1); STAGE(SB(1, 0), b3); STAGE(SB(1, 1), b3 + hstep); STAGE(SA(1, 0), a3);
      WAIT_V(8); WAIT_L(0); BAR; MMA(1, 0, At, B0); MMA(1, 1, At, B1); BAR; SCHED;
    }
    if (wr == 0) BAR;
    if (g.mode == 0) {
#pragma unroll
      for (int ai = 0; ai < 2; ++ai)
#pragma unroll
        for (int m = 0; m < 4; ++m) {
          const int row = brow + ai * HALF + wr * 64 + m * 16 + fr;
          bf16_t* rp0 = g.Ob + (size_t)row * g.N + bcol + wc * 32;
#pragma unroll
          for (int bj = 0; bj < 2; ++bj) {
            f32x4 v0 = acc[ai][bj][m][0], v1 = acc[ai][bj][m][1];
            const int gb = bcol + bj * HALF + wc * 32;
            if (g.rope != nullptr && gb >= 512 && gb < 1536 && brow < TL) {
              const int sq = row & (SEQ - 1), pos = (gb & 32) ? (sq & 63) : (sq >> 6);
              const float* rt = g.rope + (pos * 16 + 4 * fq) * 2;
              const f32x4 t0 = *(const f32x4*)rt, t1 = *(const f32x4*)(rt + 4);
              const f32x4 cs = {t0[0], t0[2], t1[0], t1[2]}, sn = {t0[1], t0[3], t1[1], t1[3]};
              const f32x4 r0 = v0 * cs - v1 * sn, r1 = v1 * cs + v0 * sn;
              v0 = r0; v1 = r1;
            }
            u32x2 a, b2; a.x = pk2(v0[0], v0[1]); a.y = pk2(v0[2], v0[3]); b2.x = pk2(v1[0], v1[1]); b2.y = pk2(v1[2], v1[3]);
            const auto sx = __builtin_amdgcn_permlane16_swap(a.x, b2.x, false, false);
            const auto sy = __builtin_amdgcn_permlane16_swap(a.y, b2.y, false, false);
            u32x4 w4; w4.x = sx[0]; w4.y = sy[0]; w4.z = sx[1]; w4.w = sy[1];
            *(u32x4*)(rp0 + bj * HALF + ((fq & 1) ? 16 + 4 * (fq - 1) : 4 * fq)) = w4;
          }
        }
    } else if (g.mode == 1) {
#pragma unroll
      for (int ai = 0; ai < 2; ++ai)
#pragma unroll
        for (int m = 0; m < 4; ++m) {
          const int row = brow + ai * HALF + wr * 64 + m * 16 + fr;
          const int vs = row < SEQ ? 0 : (row < TL ? 1 : 2);
          float* rp = g.X + (size_t)row * g.N + bcol + wc * 32 + 4 * fq;
          const float* rin = g.Xlat + (size_t)row * g.N + bcol + wc * 32 + 4 * fq;
          const float* gp = g.gate + vs * 6144 + bcol + wc * 32 + 4 * fq;
#pragma unroll
          for (int bj = 0; bj < 2; ++bj)
#pragma unroll
            for (int n = 0; n < 2; ++n) {
              const f32x4 gv = *(const f32x4*)(gp + bj * HALF + n * 16);
              f32x4 xv = *(const f32x4*)(rin + bj * HALF + n * 16);
              xv += gv * acc[ai][bj][m][n];
              *(f32x4*)(rp + bj * HALF + n * 16) = xv;
            }
        }
    } else {
      const int ldo = g.N >> 1;
#pragma unroll
      for (int ai = 0; ai < 2; ++ai)
#pragma unroll
        for (int m = 0; m < 4; ++m) {
          const int row = brow + ai * HALF + wr * 64 + m * 16 + fr;
          bf16_t* rp0 = g.Ob + (size_t)row * ldo + ((bcol + wc * 32) >> 1);
          u32x2 ob[2];
#pragma unroll
          for (int bj = 0; bj < 2; ++bj) {
            const f32x4 gg = acc[ai][bj][m][0], uu = acc[ai][bj][m][1];
            f32x4 r;
#pragma unroll
            for (int j = 0; j < 4; ++j) r[j] = gg[j] * sigmoidf_(gg[j]) * uu[j];
            ob[bj].x = pk2(r[0], r[1]); ob[bj].y = pk2(r[2], r[3]);
          }
          const auto sx = __builtin_amdgcn_permlane16_swap(ob[0].x, ob[1].x, false, false);
          const auto sy = __builtin_amdgcn_permlane16_swap(ob[0].y, ob[1].y, false, false);
          u32x4 w4; w4.x = sx[0]; w4.y = sy[0]; w4.z = sx[1]; w4.w = sy[1];
          *(u32x4*)(rp0 + ((fq & 1) ? HALF / 2 + 4 * (fq - 1) : 4 * fq)) = w4;
        }
    }
    if (!has_next) break;
#pragma unroll
    for (int a = 0; a < 2; ++a)
#pragma unroll
      for (int b = 0; b < 2; ++b)
#pragma unroll
        for (int m = 0; m < 4; ++m)
#pragma unroll
          for (int n = 0; n < 2; ++n) acc[a][b][m][n] = (f32x4){0.f, 0.f, 0.f, 0.f};
    tile = ntile; pm = npm; pn = npn; cA = nA; cB = nB;
    if (wr == 1) BAR;
  }
  if (has_work) {
    WAIT_V(0);
    BAR;
  }
  if (g.mode == 1 && g.ctx) {
    bf16_t* sAm = (bf16_t*)shm_c;
    bf16_t* sBm = sAm + 32 * 520;
#pragma unroll 1
    for (int piece = bid_(); piece < 256; piece += gstep) {
      const int rb = piece >> 4, cb = piece & 15, mt = wid >> 2, ntl = wid & 3;
      const bf16_t* Ag = g.A + (size_t)(TL + rb * 32) * K;
      const bf16_t* Bg = g.Bt + (size_t)(cb * 64) * K;
      const int prow = tid >> 6, pc = tid & 63;
      f32x4 c4 = {0.f, 0.f, 0.f, 0.f};
      u32x4 ra[4], rbv[8];
#define MLOAD(k0_) do { const int cw_ = (K - (k0_)) < 512 ? (K - (k0_)) : 512; if (pc * 8 < cw_) { \
        _Pragma("unroll") for (int u = 0; u < 4; ++u) ra[u] = *(const u32x4*)(Ag + (size_t)(prow + 8 * u) * K + (k0_) + pc * 8); \
        _Pragma("unroll") for (int u = 0; u < 8; ++u) rbv[u] = *(const u32x4*)(Bg + (size_t)(prow + 8 * u) * K + (k0_) + pc * 8); } } while (0)
      MLOAD(0);
#pragma unroll 1
      for (int k0 = 0; k0 < K; k0 += 512) {
        const int cw = (K - k0) < 512 ? (K - k0) : 512;
        __syncthreads();
        if (pc * 8 < cw) {
#pragma unroll
          for (int u = 0; u < 4; ++u) *(u32x4*)(sAm + (prow + 8 * u) * 520 + pc * 8) = ra[u];
#pragma unroll
          for (int u = 0; u < 8; ++u) *(u32x4*)(sBm + (prow + 8 * u) * 520 + pc * 8) = rbv[u];
        }
        __syncthreads();
        if (k0 + 512 < K) MLOAD(k0 + 512);
#pragma unroll 4
        for (int u = 0; u < cw / 32; ++u) {
          const bf16x8 av = *(const bf16x8*)(sAm + (mt * 16 + fr) * 520 + 32 * u + 8 * fq);
          const bf16x8 bv = *(const bf16x8*)(sBm + (ntl * 16 + fr) * 520 + 32 * u + 8 * fq);
          c4 = MFMA16(av, bv, c4);
        }
      }
#undef MLOAD
      const int col = cb * 64 + ntl * 16 + fr;
      const float gv = g.gate[2 * 6144 + col];
#pragma unroll
      for (int j = 0; j < 4; ++j) { const size_t ro = (size_t)(rb * 32 + mt * 16 + 4 * fq + j) * g.N + col; g.X[(size_t)TL * g.N + ro] = g.Xctx[ro] + gv * c4[j]; }
    }
    __syncthreads();
  }
#undef SA
#undef SB
#undef STAGE
#undef LDA
#undef LDB
#undef MMA
}

constexpr int LRU_WN = 0, LRU_CONST = 36864, LRU_CARRY = 38400, LRU_AGGW = 42496, LRU_PART = 50688, LRU_WAVE = 54784, LRU_WAVE_BYTES = 9216;

template <int MODE, int CH = -1>
DI void lru_group_unit(KP p, int l, int g, int n, char* ldsc) {
  const int tid = tid_(), lane = tid & 63, w = __builtin_amdgcn_readfirstlane(tid >> 6), fr = lane & 15, fq = lane >> 4;
  bf16_t* Wn = (bf16_t*)(ldsc + LRU_WN);
  float* cst = (float*)(ldsc + LRU_CONST);
  float* carry = (float*)(ldsc + LRU_CARRY);
  float* aggw = (float*)(ldsc + LRU_AGGW);
  float* part = (float*)(ldsc + LRU_PART);
  bf16_t* xs = (bf16_t*)(ldsc + LRU_WAVE + w * LRU_WAVE_BYTES);
  bf16_t* xcb = xs + 36 * 64;
  const bool isctx = g >= 64;
  const int b = isctx ? g - 64 : g >> 5, gi = isctx ? 0 : g & 31;
  const int L = isctx ? CTXL : SEQ;
  const int row0 = g * 256 + w * 32;
  const int t0 = gi * 256 + w * 32;
  __syncthreads();
  {
    const bf16_t* Wg = p->Wl + (size_t)((l * 4 + n) * 4) * 4096;
#pragma unroll
    for (int u = 0; u < 4; ++u) { const int q = tid + NT * u, rowi = q >> 3, pc = q & 7;
      *(u32x4*)(Wn + rowi * 72 + pc * 8) = *(const u32x4*)(Wg + rowi * 64 + pc * 8); }
    if (tid < 128) { const int dir = tid >> 6, ch = tid & 63, gch = (l * 2 + dir) * 256 + n * 64 + ch;
      cst[tid * 3 + 0] = p->lru_ba[gch]; cst[tid * 3 + 1] = p->lru_bx[gch]; cst[tid * 3 + 2] = -8.0f * log1pf(expf(-p->lru_lam[gch])); }
    for (int q = lane; q < 35 * 8; q += 64) {
      const int tt = q >> 3, pc = q & 7, t = t0 + tt - 2;
      u32x4 v = {0u, 0u, 0u, 0u};
      if (t >= 0 && t < L) v = *(const u32x4*)(p->P + (size_t)(row0 + tt - 2) * INC + n * 64 + pc * 8);
      *(u32x4*)(xs + tt * 64 + pc * 8) = v;
    }
  }
  if (MODE == 1) {
    const int seg = tid >> 7, dir = (tid >> 6) & 1, ch = tid & 63, gch = n * 64 + ch;
    const int nch = isctx ? 0 : (dir == 0 ? 1 + gi : 32 - gi);
    float ca[8], cb[8];
#pragma unroll
    for (int e8 = 0; e8 < 8; ++e8) {
      const int e = seg * 8 + e8;
      const int ee = e < nch ? e : 0;
      const int gg = ee == 0 ? 64 + b : (dir == 0 ? b * 32 + (ee - 1) : b * 32 + 32 - ee);
      const float* q = p->aggG + ((size_t)(gg * 2 + dir) * 256 + gch) * 2;
      const float a_ = q[0], b_ = q[1];
      ca[e8] = e < nch ? a_ : 1.f; cb[e8] = e < nch ? b_ : 0.f;
    }
    float A = 1.f, B = 0.f;
#pragma unroll
    for (int e8 = 0; e8 < 8; ++e8) { B = ca[e8] * B + cb[e8]; A = A * ca[e8]; }
    part[((seg * 2 + dir) * 64 + ch) * 2 + 0] = A; part[((seg * 2 + dir) * 64 + ch) * 2 + 1] = B;
  }
  __syncthreads();
  {
    const int ch = lane;
    const float* cw = p->conv_w + l * 4 * 256 + n * 64 + ch;
    const float cb_ = p->conv_b[l * 256 + n * 64 + ch];
    const float w0 = cw[0], w1 = cw[256], w2 = cw[512], w3 = cw[768];
    float x0 = bf2f(xs[ch]), x1 = bf2f(xs[64 + ch]), x2 = bf2f(xs[128 + ch]);
#pragma unroll 8
    for (int t = 0; t < 32; ++t) {
      const float x3 = bf2f(xs[(t + 3) * 64 + ch]);
      const float y = cb_ + w0 * x0 + w1 * x1 + w2 * x2 + w3 * x3;
      xcb[t * 72 + ch] = (bf16_t)f2bf(y);
      x0 = x1; x1 = x2; x2 = x3;
    }
  }
  if (MODE == 1 && tid < 128) {
    const int dir = tid >> 6, ch = tid & 63, gch = n * 64 + ch;
    float h = 0.f;
#pragma unroll
    for (int sg = 0; sg < 4; ++sg) h = part[((sg * 2 + dir) * 64 + ch) * 2] * h + part[((sg * 2 + dir) * 64 + ch) * 2 + 1];
    float sa[8], sb[8];
#pragma unroll
    for (int w2 = 0; w2 < 8; ++w2) { const float* q = p->aggS + ((size_t)((g * 8 + w2) * 2 + dir) * 256 + gch) * 2; sa[w2] = q[0]; sb[w2] = q[1]; }
#pragma unroll
    for (int i = 0; i < 8; ++i) { const int w2 = dir == 0 ? i : 7 - i; carry[(w2 * 2 + dir) * 64 + ch] = h; h = sa[w2] * h + sb[w2]; }
  }
  __syncthreads();
  bf16x8 af[2][2];
#pragma unroll
  for (int m = 0; m < 2; ++m)
#pragma unroll
    for (int ks = 0; ks < 2; ++ks) af[m][ks] = *(const bf16x8*)(xcb + (16 * m + fr) * 72 + 32 * ks + 8 * fq);
  float hf[4][2][4];
#pragma unroll
  for (int dir = 0; dir < 2; ++dir)
#pragma unroll
    for (int cg = 0; cg < 4; ++cg) {
      if (CH >= 0 && (cg >> 1) != CH) continue;
      const int ch = cg * 16 + fr;
      float gl[2][4];
      if (MODE == 1 && dir == 1) {
#pragma unroll
        for (int m = 0; m < 2; ++m)
#pragma unroll
          for (int j = 0; j < 4; ++j) gl[m][j] = bf2f(p->P[(size_t)(row0 + 16 * m + 4 * fq + j) * INC + 256 + n * 64 + ch]);
      }
      bf16x8 bfr[2][2];
#pragma unroll
      for (int kind = 0; kind < 2; ++kind)
#pragma unroll
        for (int ks = 0; ks < 2; ++ks) bfr[kind][ks] = *(const bf16x8*)(Wn + ((dir * 2 + kind) * 64 + ch) * 72 + 32 * ks + 8 * fq);
      f32x4 acc[2][2];
#pragma unroll
      for (int m = 0; m < 2; ++m)
#pragma unroll
        for (int kind = 0; kind < 2; ++kind) acc[m][kind] = (f32x4){0.f, 0.f, 0.f, 0.f};
#pragma unroll
      for (int m = 0; m < 2; ++m)
#pragma unroll
        for (int ks = 0; ks < 2; ++ks)
#pragma unroll
          for (int kind = 0; kind < 2; ++kind) acc[m][kind] = MFMA16(af[m][ks], bfr[kind][ks], acc[m][kind]);
      const float ba = cst[(dir * 64 + ch) * 3], bx = cst[(dir * 64 + ch) * 3 + 1], ls8 = cst[(dir * 64 + ch) * 3 + 2];
      float a[2][4], bb[2][4];
#pragma unroll
      for (int m = 0; m < 2; ++m)
#pragma unroll
        for (int j = 0; j < 4; ++j) {
          const int t = 16 * m + 4 * fq + j;
          const float r = sigmoidf_(acc[m][0][j] + ba), ig = sigmoidf_(acc[m][1][j] + bx);
          const float la = ls8 * r, x2 = 2.0f * la;
          a[m][j] = __expf(la);
          const float em = -x2 * (1.0f + x2 * (0.5f + x2 * (0.16666667f + x2 * (0.041666668f + x2 * 0.0083333338f))));
          bb[m][j] = __builtin_amdgcn_sqrtf(em) * (ig * bf2f(xcb[t * 72 + ch]));
        }
      float IA[2], IB[2], TA[2], TB[2];
      const int src1 = (dir == 0 ? lane - 16 : lane + 16) & 63, src2 = (dir == 0 ? lane - 32 : lane + 32) & 63;
      const bool v1 = dir == 0 ? fq >= 1 : fq <= 2, v2 = dir == 0 ? fq >= 2 : fq <= 1;
      const int lastl = dir == 0 ? fr + 48 : fr;
#pragma unroll
      for (int m = 0; m < 2; ++m) {
        float A = 1.f, B = 0.f;
#pragma unroll
        for (int jj = 0; jj < 4; ++jj) { const int j = dir == 0 ? jj : 3 - jj; B = a[m][j] * B + bb[m][j]; A = A * a[m][j]; }
        float ua = __shfl(A, src1), ub = __shfl(B, src1);
        if (v1) { B = A * ub + B; A = A * ua; }
        ua = __shfl(A, src2); ub = __shfl(B, src2);
        if (v2) { B = A * ub + B; A = A * ua; }
        IA[m] = A; IB[m] = B;
        TA[m] = __shfl(A, lastl); TB[m] = __shfl(B, lastl);
      }
      const int mf = dir == 0 ? 0 : 1, ms = 1 - mf;
      if (MODE == 0) {
        if (fq == 0) {
          const float A = TA[ms] * TA[mf], B = TA[ms] * TB[mf] + TB[ms];
          float* q = p->aggS + ((size_t)((g * 8 + w) * 2 + dir) * 256 + n * 64 + ch) * 2;
          q[0] = A; q[1] = B;
          aggw[((w * 2 + dir) * 64 + ch) * 2] = A; aggw[((w * 2 + dir) * 64 + ch) * 2 + 1] = B;
        }
      } else {
        const float c = carry[(w * 2 + dir) * 64 + ch];
#pragma unroll
        for (int mi = 0; mi < 2; ++mi) {
          const int m = mi == 0 ? mf : ms;
          const float hin = mi == 0 ? c : TA[mf] * c + TB[mf];
          float ea = __shfl(IA[m], src1), eb = __shfl(IB[m], src1);
          if (!v1) { ea = 1.f; eb = 0.f; }
          float h = ea * hin + eb;
#pragma unroll
          for (int jj = 0; jj < 4; ++jj) {
            const int j = dir == 0 ? jj : 3 - jj;
            h = a[m][j] * h + bb[m][j];
            if (dir == 0) hf[cg][m][j] = h;
            else {
              const float y = hf[cg][m][j] + h, gv = gl[m][j];
              const float u = 0.7978845608028654f * (gv + 0.044715f * gv * gv * gv);
              p->MIX[(size_t)(row0 + 16 * m + 4 * fq + j) * D + n * 64 + ch] = (bf16_t)f2bf(y * gv * sigmoidf_(2.0f * u));
            }
          }
        }
      }
    }
  if (MODE == 0) {
    __syncthreads();
    if (tid < 128 && (CH < 0 || ((tid & 63) >> 5) == CH)) {
      const int dir = tid >> 6, ch = tid & 63;
      float A = 1.f, B = 0.f;
#pragma unroll
      for (int i = 0; i < 8; ++i) { const int w2 = dir == 0 ? i : 7 - i; const float a_ = aggw[((w2 * 2 + dir) * 64 + ch) * 2], b_ = aggw[((w2 * 2 + dir) * 64 + ch) * 2 + 1]; B = a_ * B + b_; A = A * a_; }
      float* q = p->aggG + ((size_t)(g * 2 + dir) * 256 + n * 64 + ch) * 2;
      q[0] = A; q[1] = B;
    }
  }
}

DI void phase_prep(KP p, int l, char* ldsc) {
  const int tid = tid_();
  constexpr int U_TR = 264 * 3;
#pragma unroll 1
  for (int r = bid_(); r < 256; r += gdim_()) lru_group_unit<0>(p, l, r >> 2, r & 3, ldsc);
#pragma unroll 1
  for (int u = bid_() - 8; u >= 0 && u < 16; u += gdim_()) {
    if (u & 1) lru_group_unit<0, 1>(p, l, 64 + (u >> 3), (u >> 1) & 3, ldsc); else lru_group_unit<0, 0>(p, l, 64 + (u >> 3), (u >> 1) & 3, ldsc);
  }
#pragma unroll 1
  for (int r = bid_() < 8 ? bid_() : bid_() - 16; r >= 0 && r < U_TR && (bid_() < 8 || bid_() >= 24); r += gdim_() - 16) {
    {

      const int chunk = r / 3, cgp = r % 3;
      int row0, b, keypos;
      if (chunk < 256) { b = chunk >> 7; row0 = chunk * 64; keypos = CTXL + (chunk & 127) * 64; }
      else { const int cc = chunk - 256; b = cc >> 2; row0 = TL + cc * 64; keypos = (cc & 3) * 64; }
      const int colbase = cgp < 2 ? 1536 + cgp * 256 : 2560;
      bf16_t* Tt = (bf16_t*)ldsc;
      __syncthreads();
#pragma unroll
      for (int uu = 0; uu < 4; ++uu) {
        const int q = tid + NT * uu, rr = q >> 5, pc = q & 31;
        *(u32x4*)(Tt + rr * 264 + pc * 8) = *(const u32x4*)(p->P + (size_t)(row0 + rr) * INC + colbase + pc * 8);
      }
      __syncthreads();
#pragma unroll
      for (int uu = 0; uu < 4; ++uu) {
        const int q = tid + NT * uu, c = q >> 3, pk = q & 7;
        const bf16_t* s = Tt + (8 * pk) * 264 + c;
        u32x4 o;
        o.x = (unsigned)s[0] | ((unsigned)s[264] << 16); o.y = (unsigned)s[2 * 264] | ((unsigned)s[3 * 264] << 16);
        o.z = (unsigned)s[4 * 264] | ((unsigned)s[5 * 264] << 16); o.w = (unsigned)s[6 * 264] | ((unsigned)s[7 * 264] << 16);
        bf16_t* dst;
        if (cgp < 2) { const int h = cgp * 2 + (c >> 7), dv = c & 127; dst = p->Vtd + ((size_t)((b * 4 + h) * 128 + dv)) * NKEY + keypos + 8 * pk; }
        else { const int h = c >> 6, dv = c & 63; dst = p->Vtn + ((size_t)((b * 4 + h) * 64 + dv)) * NKEY + keypos + 8 * pk; }
        *(u32x4*)dst = o;
      }
    }
  }
}

constexpr float QK_C = 0.125f * 1.4426950408889634f;
constexpr float LOG2E = 1.4426950408889634f;

typedef __attribute__((address_space(3))) unsigned char lds_u8;
typedef __attribute__((address_space(3))) bf16x8 lds_bf16x8;
#define GLDS16(gp, lp) __builtin_amdgcn_global_load_lds((const unsigned*)(gp), (__attribute__((address_space(3))) unsigned*)(lp), 16, 0, 0)
template <int DV, bool LOCAL>
DI void attn_tile(const bf16x8 (&qf)[4], const lds_u8* Kb, const lds_u8* Vb, const int (&ko)[4], const int (&vo)[4], f32x16 (&o)[DV / 32], float& m, float& l, int hh,
                  const float* rpbs, int drow, int cq, int c0) {
  constexpr int ND = DV / 32;
#define ASCHED __builtin_amdgcn_sched_barrier(0)
  f32x16 st[2];
  {
    bf16x8 kf[2][4];
#pragma unroll
    for (int t = 0; t < 2; ++t)
#pragma unroll
      for (int ks = 0; ks < 4; ++ks) kf[t][ks] = *(const lds_bf16x8*)(Kb + ko[ks] + t * 4096);
    ASCHED;
#pragma unroll
    for (int t = 0; t < 2; ++t) {
      f32x16 s;
#pragma unroll
      for (int i = 0; i < 16; ++i) s[i] = 0.f;
#pragma unroll
      for (int ks = 0; ks < 4; ++ks) s = MFMA32(kf[t][ks], qf[ks], s);
      st[t] = s;
    }
  }
  bf16x8 va[2][ND];
#pragma unroll
  for (int s2 = 0; s2 < 2; ++s2)
#pragma unroll
    for (int d = 0; d < ND; ++d) va[s2][d] = *(const lds_bf16x8*)(Vb + vo[s2] + d * 4096);
  ASCHED;
  float mx = -3.0e38f;
  if (LOCAL) {
#pragma unroll
    for (int t = 0; t < 2; ++t)
#pragma unroll
      for (int i = 0; i < 16; ++i) {
        const int ck = 32 * t + 16 * (i >> 3) + 8 * hh + (i & 7);
        const int dc = ck - cq + 15;
        const bool ok = (ck >= c0) && (ck < c0 + 16);
        const int dcc = dc < 0 ? 0 : (dc > 30 ? 30 : dc);
        const float z = ok ? __builtin_fmaf(st[t][i], QK_C, rpbs[drow * 31 + dcc]) : -1.0e30f;
        st[t][i] = z; mx = fmaxf(mx, z);
      }
  } else {
#pragma unroll
    for (int t = 0; t < 2; ++t)
#pragma unroll
      for (int i = 0; i < 16; ++i) mx = fmaxf(mx, st[t][i]);
    mx *= QK_C;
  }
  mx = xhalf_max(mx);
  if (!__all(mx <= m + 8.0f)) {
    const float mn = fmaxf(m, mx);
    const float alpha = __builtin_amdgcn_exp2f(m - mn);
    m = mn; l *= alpha;
#pragma unroll
    for (int d = 0; d < ND; ++d) o[d] *= alpha;
  }
  float ps = 0.f;
#pragma unroll
  for (int t = 0; t < 2; ++t)
#pragma unroll
    for (int i = 0; i < 16; ++i) {
      const float pv = LOCAL ? __builtin_amdgcn_exp2f(st[t][i] - m) : __builtin_amdgcn_exp2f(__builtin_fmaf(st[t][i], QK_C, -m));
      st[t][i] = pv; ps += pv;
    }
  l += ps;
  ASCHED;
  bf16x8 vb[2][ND];
#pragma unroll
  for (int s2 = 0; s2 < 2; ++s2)
#pragma unroll
    for (int d = 0; d < ND; ++d) vb[s2][d] = *(const lds_bf16x8*)(Vb + vo[2 + s2] + d * 4096);
#pragma unroll
  for (int s2 = 0; s2 < 2; ++s2) {
    u32x4 pw;
    pw.x = pk2(st[0][8 * s2 + 0], st[0][8 * s2 + 1]); pw.y = pk2(st[0][8 * s2 + 2], st[0][8 * s2 + 3]);
    pw.z = pk2(st[0][8 * s2 + 4], st[0][8 * s2 + 5]); pw.w = pk2(st[0][8 * s2 + 6], st[0][8 * s2 + 7]);
    const bf16x8 pf = __builtin_bit_cast(bf16x8, pw);
#pragma unroll
    for (int d = 0; d < ND; ++d) o[d] = MFMA32(va[s2][d], pf, o[d]);
  }
  ASCHED;
#pragma unroll
  for (int s2 = 0; s2 < 2; ++s2) {
    u32x4 pw;
    pw.x = pk2(st[1][8 * s2 + 0], st[1][8 * s2 + 1]); pw.y = pk2(st[1][8 * s2 + 2], st[1][8 * s2 + 3]);
    pw.z = pk2(st[1][8 * s2 + 4], st[1][8 * s2 + 5]); pw.w = pk2(st[1][8 * s2 + 6], st[1][8 * s2 + 7]);
    const bf16x8 pf = __builtin_bit_cast(bf16x8, pw);
#pragma unroll
    for (int d = 0; d < ND; ++d) o[d] = MFMA32(vb[s2][d], pf, o[d]);
  }
#undef ASCHED
}

DI void qk_tile(const bf16x8 (&qf)[4], const lds_u8* Kb, const int (&ko)[4], f32x16 (&st)[2]) {
  bf16x8 kf[2][4];
#pragma unroll
  for (int t = 0; t < 2; ++t)
#pragma unroll
    for (int ks = 0; ks < 4; ++ks) kf[t][ks] = *(const lds_bf16x8*)(Kb + ko[ks] + t * 4096);
#pragma unroll
  for (int t = 0; t < 2; ++t) {
    f32x16 s;
#pragma unroll
    for (int i = 0; i < 16; ++i) s[i] = 0.f;
#pragma unroll
    for (int ks = 0; ks < 4; ++ks) s = MFMA32(kf[t][ks], qf[ks], s);
    st[t] = s;
  }
}
DI void pv_grp(f32x16 (&o)[4], const bf16x8 (&v)[4], const bf16x8& Pq) {
#pragma unroll
  for (int d = 0; d < 4; ++d) o[d] = MFMA32(v[d], Pq, o[d]);
}
template <int Q>
DI float exp_pack1(const f32x16 (&st)[2], float m, bf16x8& Pq) {
  float e[8]; float ps = 0.f;
#pragma unroll
  for (int j = 0; j < 8; ++j) { e[j] = __builtin_amdgcn_exp2f(__builtin_fmaf(st[Q >> 1][8 * (Q & 1) + j], QK_C, -m)); ps += e[j]; }
  u32x4 pw; pw.x = pk2(e[0], e[1]); pw.y = pk2(e[2], e[3]); pw.z = pk2(e[4], e[5]); pw.w = pk2(e[6], e[7]);
  Pq = __builtin_bit_cast(bf16x8, pw);
  return ps;
}
DI float exp_pack(const f32x16 (&st)[2], float m, bf16x8 (&Pn)[4]) {
  return (exp_pack1<0>(st, m, Pn[0]) + exp_pack1<1>(st, m, Pn[1])) + (exp_pack1<2>(st, m, Pn[2]) + exp_pack1<3>(st, m, Pn[3]));
}
DI float tile_max(const f32x16 (&st)[2]) {
  float mx = st[0][0];
#pragma unroll
  for (int t = 0; t < 2; ++t)
#pragma unroll
    for (int i = 0; i < 16; ++i) mx = fmaxf(mx, st[t][i]);
  mx *= QK_C;
  return xhalf_max(mx);
}

DI void diff_unit(KP p, int l, int b, int h, int qb, int isctx, float lamv, float lam_init, char* ldsc) {
  const int tid = tid_(), lane = tid & 63, w = __builtin_amdgcn_readfirstlane(tid >> 6), r = lane & 31, hh = lane >> 5;
  const int pr = (r & ~12) | ((r & 4) << 1) | ((r & 8) >> 1);
  const int comp = w & 1, grp = w >> 1;
  const int qrow = (isctx ? TL + b * CTXL : b * SEQ) + qb * 128 + grp * 32 + r;
  const int nt = isctx ? 4 : 132;
  lds_u8* L = (lds_u8*)ldsc;
  constexpr int STG = 32768;
  int ko[4], vo[4];
#pragma unroll
  for (int ks = 0; ks < 4; ++ks) ko[ks] = pr * 128 + (((2 * ks + hh) ^ ((pr >> 1) & 7)) << 4);
#pragma unroll
  for (int q = 0; q < 4; ++q) vo[q] = r * 128 + (((2 * q + hh) ^ ((r >> 1) & 7)) << 4);
  bf16x8 qf[4];
#pragma unroll
  for (int ks = 0; ks < 4; ++ks) qf[ks] = *(const bf16x8*)(p->P + (size_t)qrow * INC + 512 + h * 128 + comp * 64 + 16 * ks + 8 * hh);
  f32x16 o[4];
#pragma unroll
  for (int d = 0; d < 4; ++d)
#pragma unroll
    for (int i = 0; i < 16; ++i) o[d][i] = 0.f;
  float m, lsum;
  const bf16_t* vt = p->Vtd + (size_t)((b * 4 + h) * 128) * NKEY;
  const bf16_t* Pk = p->P + 1024 + h * 128;
  const int row8 = 8 * w + (lane >> 3), swz = ((lane & 7) ^ ((row8 >> 1) & 7)) << 4;
  const unsigned kq = (unsigned)(row8 * (INC * 2) + swz), vq = (unsigned)(row8 * (NKEY * 2) + swz);
#define DISSUE(kt, stg) do { const int krow_ = (kt) < 4 ? TL + b * CTXL + (kt) * 64 : b * SEQ + ((kt) - 4) * 64; \
    const char* kb_ = (const char*)(Pk + (size_t)krow_ * INC) + kq; const char* vb_ = (const char*)(vt + (kt) * 64) + vq; \
    lds_u8* sb_ = L + (stg) * STG + w * 1024; \
    GLDS16(kb_, sb_); GLDS16(kb_ + 128, sb_ + 8192); GLDS16(vb_, sb_ + 16384); GLDS16(vb_ + (size_t)64 * NKEY * 2, sb_ + 24576); } while (0)
#define VLOAD(dst, sbv, q) do { _Pragma("unroll") for (int d_ = 0; d_ < 4; ++d_) dst[d_] = *(const lds_bf16x8*)((sbv) + vo[q] + d_ * 4096); } while (0)
  asm volatile("s_waitcnt vmcnt(0)" ::: "memory");
  __syncthreads();
  DISSUE(0, 0);
  DISSUE(1, 1);
  asm volatile("s_waitcnt vmcnt(4)" ::: "memory");
  __builtin_amdgcn_s_barrier();
  bf16x8 P[4];
  {
    f32x16 st[2];
    qk_tile(qf, L + comp * 8192, ko, st);
    m = tile_max(st);
    lsum = exp_pack(st, m, P);
  }
  int stg = 0;
  bool need = false; float alpha = 1.f;
  if (w >= 4) __builtin_amdgcn_s_setprio(1);
  bf16x8 vA[4], vB[4];
  VLOAD(vA, L + 16384, 0); VLOAD(vB, L + 16384, 1);
#define FENCE __builtin_amdgcn_sched_barrier(0)
#pragma unroll 1
  for (int kt = 0; kt < nt - 1; ++kt) {
    asm volatile("s_waitcnt vmcnt(0)" ::: "memory");
    __builtin_amdgcn_s_barrier();
    const int stg1 = stg == 2 ? 0 : stg + 1;
    if (kt + 2 < nt) { const int s2_ = stg >= 1 ? stg - 1 : 2; DISSUE(kt + 2, s2_); }
    if (need) {
#pragma unroll
      for (int d = 0; d < 4; ++d) o[d] *= alpha;
    }
    const lds_u8* sbv = L + stg * STG + 16384;
    const lds_u8* sbk = L + stg1 * STG + comp * 8192;
    bf16x8 kf[2][4];
    f32x16 st[2];
#pragma unroll
    for (int t = 0; t < 2; ++t)
#pragma unroll
      for (int ks = 0; ks < 4; ++ks) kf[t][ks] = *(const lds_bf16x8*)(sbk + ko[ks] + t * 4096);
    FENCE;
    pv_grp(o, vA, P[0]); pv_grp(o, vB, P[1]);
    VLOAD(vA, sbv, 2); VLOAD(vB, sbv, 3);
    FENCE;
#pragma unroll
    for (int i = 0; i < 16; ++i) { st[0][i] = 0.f; st[1][i] = 0.f; }
#pragma unroll
    for (int ks = 0; ks < 4; ++ks) st[0] = MFMA32(kf[0][ks], qf[ks], st[0]);
#pragma unroll
    for (int ks = 0; ks < 4; ++ks) st[1] = MFMA32(kf[1][ks], qf[ks], st[1]);
    FENCE;
    pv_grp(o, vA, P[2]);
    const float mx = tile_max(st);
    need = !__all(mx <= m + 8.0f);
    const float mn = need ? fmaxf(m, mx) : m;
    alpha = __builtin_amdgcn_exp2f(m - mn);
    FENCE;
    float ps = exp_pack1<0>(st, mn, P[0]);
    ps += exp_pack1<1>(st, mn, P[1]);
    ps += exp_pack1<2>(st, mn, P[2]);
    pv_grp(o, vB, P[3]);
    ps += exp_pack1<3>(st, mn, P[3]);
#pragma unroll
    for (int q = 0; q < 4; ++q) { __builtin_amdgcn_sched_group_barrier(0x402, 18, 0); __builtin_amdgcn_sched_group_barrier(0x008, 1, 0); }
    lsum = lsum * alpha + ps; m = mn;
    FENCE;
    { const lds_u8* sbn = L + stg1 * STG + 16384; VLOAD(vA, sbn, 0); VLOAD(vB, sbn, 1); }
    stg = stg1;
  }
  __builtin_amdgcn_s_setprio(0);
  if (need) {
#pragma unroll
    for (int d = 0; d < 4; ++d) o[d] *= alpha;
  }
  {
    const lds_u8* sbv = L + stg * STG + 16384;
    pv_grp(o, vA, P[0]); pv_grp(o, vB, P[1]);
    VLOAD(vA, sbv, 2); VLOAD(vB, sbv, 3);
    pv_grp(o, vA, P[2]);
    pv_grp(o, vB, P[3]);
  }
#undef FENCE
#undef DISSUE
#undef VLOAD
  __syncthreads();
  const float ltot = lsum + __shfl_xor(lsum, 32);
  const float inv = 1.0f / ltot;
  float* Ob = (float*)ldsc + grp * 4096 + lane;
  if (comp == 1) {
#pragma unroll
    for (int d = 0; d < 4; ++d)
#pragma unroll
      for (int i = 0; i < 16; ++i) Ob[(d * 16 + i) * 64] = o[d][i] * inv;
  }
  __syncthreads();
  if (comp == 0) {
    float ss = 0.f;
#pragma unroll
    for (int d = 0; d < 4; ++d)
#pragma unroll
      for (int i = 0; i < 16; ++i) { const float v = o[d][i] * inv - lamv * Ob[(d * 16 + i) * 64]; o[d][i] = v; ss += v * v; }
    ss += __shfl_xor(ss, 32);
    const float sc = (1.0f - lam_init) / sqrtf(ss * (1.0f / 128.0f) + 1e-6f);
    const float* sg = p->subln_g + l * 128;
    bf16_t* mrow = p->MIX + (size_t)qrow * D + 256 + h * 128;
#pragma unroll
    for (int d = 0; d < 4; ++d)
#pragma unroll
      for (int i4 = 0; i4 < 4; ++i4) {
        const int dv = 32 * d + 8 * i4 + 4 * hh;
        const f32x4 gv = *(const f32x4*)(sg + dv);
        u32x2 ov; ov.x = pk2(o[d][4 * i4 + 0] * sc * gv[0], o[d][4 * i4 + 1] * sc * gv[1]); ov.y = pk2(o[d][4 * i4 + 2] * sc * gv[2], o[d][4 * i4 + 3] * sc * gv[3]);
        *(u32x2*)(mrow + dv) = ov;
      }
  }
}

DI void na_unit(KP p, int l, int b, int h, int rb, int isctx, char* ldsc) {
  const int tid = tid_(), lane = tid & 63, w = __builtin_amdgcn_readfirstlane(tid >> 6), r = lane & 31, hh = lane >> 5;
  const int pr = (r & ~12) | ((r & 4) << 1) | ((r & 8) >> 1);
  const int rq0 = rb * 4, rq = rq0 + (w >> 1), cq = (w & 1) * 32 + r;
  const int qrow = isctx ? TL + b * CTXL + w * 32 + r : b * SEQ + rq * 64 + cq;
  const int r0w = min(max(rq - 4, 0), 120);
  const int c0 = min(max(cq - 8, 0), 48);
  const int rlo = min(max(rq0 - 4, 0), 120), rhi = min(max(rq0 + 3 - 4, 0), 120) + 7;
  const int nt = isctx ? 4 : 4 + (rhi - rlo + 1);
  lds_u8* L = (lds_u8*)ldsc;
  float* rpbs = (float*)(ldsc + LDS_CONST + 64);
  constexpr int STG = 16384;
  int ko[4], vo[4];
#pragma unroll
  for (int ks = 0; ks < 4; ++ks) ko[ks] = pr * 128 + (((2 * ks + hh) ^ ((pr >> 1) & 7)) << 4);
#pragma unroll
  for (int q = 0; q < 4; ++q) vo[q] = r * 128 + (((2 * q + hh) ^ ((r >> 1) & 7)) << 4);
  asm volatile("s_waitcnt vmcnt(0)" ::: "memory");
  __syncthreads();
  if (!isctx) for (int e = tid; e < 465; e += NT) rpbs[e] = p->rpb[(size_t)(l * 4 + h) * 465 + e] * LOG2E;
  bf16x8 qf[4];
#pragma unroll
  for (int ks = 0; ks < 4; ++ks) qf[ks] = *(const bf16x8*)(p->P + (size_t)qrow * INC + 2048 + h * 64 + 16 * ks + 8 * hh);
  f32x16 o[2];
#pragma unroll
  for (int d = 0; d < 2; ++d)
#pragma unroll
    for (int i = 0; i < 16; ++i) o[d][i] = 0.f;
  float m = -3.0e38f, lsum = 0.f;
  const bf16_t* vt = p->Vtn + (size_t)((b * 4 + h) * 64) * NKEY;
  const bf16_t* Pk = p->P + 2304 + h * 64;
  const int row8 = 8 * w + (lane >> 3), swz = ((lane & 7) ^ ((row8 >> 1) & 7)) << 4;
  const unsigned kq = (unsigned)(row8 * (INC * 2) + swz), vq = (unsigned)(row8 * (NKEY * 2) + swz);
#define NISSUE(kt, stg) do { const int kr_ = (kt) < 4 ? TL + b * CTXL + (kt) * 64 : b * SEQ + (rlo + (kt) - 4) * 64; const int kp_ = (kt) < 4 ? (kt) * 64 : CTXL + (rlo + (kt) - 4) * 64; \
    lds_u8* sb_ = L + (stg) * STG + w * 1024; \
    GLDS16((const char*)(Pk + (size_t)kr_ * INC) + kq, sb_); GLDS16((const char*)(vt + kp_) + vq, sb_ + 8192); } while (0)
  asm volatile("s_waitcnt vmcnt(0)" ::: "memory");
  NISSUE(0, 0);
  NISSUE(1, 1);
  int stg = 0;
#pragma unroll 1
  for (int kt = 0; kt < nt; ++kt) {
    if (kt + 1 < nt) asm volatile("s_waitcnt vmcnt(2)" ::: "memory"); else asm volatile("s_waitcnt vmcnt(0)" ::: "memory");
    asm volatile("s_waitcnt lgkmcnt(0)" ::: "memory");
    __builtin_amdgcn_s_barrier();
    if (kt + 2 < nt) { const int s2_ = stg >= 1 ? stg - 1 : 2; NISSUE(kt + 2, s2_); }
    const lds_u8* sb = L + stg * STG;
    if (kt < 4) attn_tile<64, false>(qf, sb, sb + 8192, ko, vo, o, m, lsum, hh, nullptr, 0, 0, 0);
    else {
      const int rk = rlo + kt - 4;
      if (rk >= r0w && rk < r0w + 8) attn_tile<64, true>(qf, sb, sb + 8192, ko, vo, o, m, lsum, hh, rpbs, rk - rq + 7, cq, c0);
    }
    stg = stg == 2 ? 0 : stg + 1;
  }
#undef NISSUE
  const float ltot = lsum + __shfl_xor(lsum, 32);
  const float inv = 1.0f / ltot;
  bf16_t* mrow = p->MIX + (size_t)qrow * D + 768 + h * 64;
#pragma unroll
  for (int d = 0; d < 2; ++d)
#pragma unroll
    for (int i4 = 0; i4 < 4; ++i4) {
      const int dv = 32 * d + 8 * i4 + 4 * hh;
      u32x2 ov; ov.x = pk2(o[d][4 * i4 + 0] * inv, o[d][4 * i4 + 1] * inv); ov.y = pk2(o[d][4 * i4 + 2] * inv, o[d][4 * i4 + 3] * inv);
      *(u32x2*)(mrow + dv) = ov;
    }
}

DI void phase_attn(KP p, int l, char* ldsc) {
  const bool last = l == DEPTH - 1;
  const float lam_init = 0.8f - 0.6f * expf(-0.3f * (float)l);
  float* cst = (float*)(ldsc + LDS_CONST);
  __syncthreads();
  if (tid_() < 64) {
    const float* dl = p->diff_lam + l * 256;
    const int i = tid_();
    const float s1 = wave_sum(dl[i] * dl[64 + i]), s2 = wave_sum(dl[128 + i] * dl[192 + i]);
    if (i == 0) cst[0] = expf(s1) - expf(s2) + lam_init;
  }
  __syncthreads();
  const float lamv = cst[0];
  const int nb = gdim_(), bid = bid_();
#pragma unroll 1
  for (int r = bid; r < 512; r += nb) diff_unit(p, l, r >> 8, (r >> 6) & 3, r & 63, 0, lamv, lam_init, ldsc);
#if PROBE_DUP == 6
#pragma unroll 1
  for (int r = bid; r < 512; r += nb) diff_unit(p, l, r >> 8, (r >> 6) & 3, r & 63, 0, lamv, lam_init, ldsc);
#endif
#pragma unroll 1
  for (int r = bid; r < 256; r += nb) na_unit(p, l, r >> 7, (r >> 5) & 3, r & 31, 0, ldsc);
#pragma unroll 1
  for (int r = bid; r < 256; r += nb) lru_group_unit<1>(p, l, r >> 2, r & 3, ldsc);
  if (!last) {
#pragma unroll 1
    for (int u = bid; u < 16; u += nb) { if (u & 1) lru_group_unit<1, 1>(p, l, 64 + (u >> 3), (u >> 1) & 3, ldsc); else lru_group_unit<1, 0>(p, l, 64 + (u >> 3), (u >> 1) & 3, ldsc); }
  }
#if PROBE_DUP == 4
#pragma unroll 1
  for (int r = bid; r < (last ? 64 : 66) * 4; r += nb) lru_group_unit<1>(p, l, r >> 2, r & 3, ldsc);
#endif
#if PROBE_DUP == 5
#pragma unroll 1
  for (int r = bid; r < 256; r += nb) na_unit(p, l, r >> 7, (r >> 5) & 3, r & 31, 0, ldsc);
#endif
  if (!last) {
#pragma unroll 1
    for (int r = nb - 1 - bid; r < 16; r += nb) diff_unit(p, l, r >> 3, (r >> 1) & 3, r & 1, 1, lamv, lam_init, ldsc);
#pragma unroll 1
    for (int r = nb - 17 - bid; r >= 0 && r < 8; r += nb) na_unit(p, l, r >> 2, r & 3, 0, 1, ldsc);
  }
}

__global__ void __launch_bounds__(512) mega(Params pv) {
  extern __shared__ __attribute__((aligned(16))) char lds[];
  cg::grid_group grid = cg::this_grid();
  volatile LAS unsigned* xst = (volatile LAS unsigned*)((LAS char*)lds + 131072);
  if (threadIdx.x == 0) { xst[0] = 0u; xst[1] = 0u; xst[2] = 0u; xst[3] = 0u; }
  __syncthreads();
  (void)xcd_barrier_post(get_params()->bar, xst);
#define XBAR() do { XcdBarrier xb_; xb_.bar = get_params()->bar; xb_.x = xb_xcc_id(); xb_.st = (volatile LAS unsigned*)((LAS char*)lds + 131072); xcd_barrier(xb_); } while (0)
  phase_prologue(get_params(), lds);
  if (gridDim.x == 0x7fffffffu) grid.sync();
  XBAR();
#pragma unroll 1
  for (int l = 0; l < DEPTH; ++l) {
    const bool last = l == DEPTH - 1;
    const int Mr = last ? TL : T;
    { KP p = get_params(); phase_norm(p, p->norm1_g + l * D, p->mods + (size_t)l * 3 * 6144, 0, 1, T, l ? p->X : p->x, l ? p->X + (size_t)TL * D : p->ctx); }
    XBAR();
#if PROBE_DUP == 2
    { KP p = get_params(); GemmArgs g; g.A = p->H; g.Bt = p->Win_t + (size_t)l * INC * D; g.M = T; g.N = INC; g.K = D; g.ctx = 0; g.mode = 0; g.Ob = p->P; g.X = nullptr; g.gate = nullptr; g.rope = p->rope; g.Xlat = nullptr; g.Xctx = nullptr; gemm_phase(g, lds); }
    XBAR();
#endif
    { KP p = get_params(); GemmArgs g; g.A = p->H; g.Bt = p->Win_t + (size_t)l * INC * D; g.M = T; g.N = INC; g.K = D; g.ctx = 0; g.mode = 0; g.Ob = p->P; g.X = nullptr; g.gate = nullptr; g.rope = p->rope; g.Xlat = nullptr; g.Xctx = nullptr; gemm_phase(g, lds); }
    XBAR();
    phase_prep(get_params(), l, lds);
    XBAR();
    phase_attn(get_params(), l, lds);
    XBAR();
#if PROBE_DUP == 1
    phase_attn(get_params(), l, lds);
    XBAR();
#endif
#if PROBE_DUP == 2
    { KP p = get_params(); GemmArgs g; g.A = p->MIX; g.Bt = p->Wout_t + (size_t)l * D * D; g.M = Mr; g.N = D; g.K = D; g.ctx = 0; g.mode = 0; g.Ob = p->P; g.X = nullptr; g.gate = nullptr; g.rope = nullptr; g.Xlat = nullptr; g.Xctx = nullptr; gemm_phase(g, lds); }
    XBAR();
#endif
    { KP p = get_params(); GemmArgs g; g.A = p->MIX; g.Bt = p->Wout_t + (size_t)l * D * D; g.M = TL; g.ctx = !last; g.N = D; g.K = D; g.mode = 1; g.Ob = nullptr; g.X = p->X; g.gate = p->mods + (size_t)l * 3 * 6144 + 2 * 1024; g.rope = nullptr; g.Xlat = l ? p->X : p->x; g.Xctx = l ? p->X + (size_t)TL * D : p->ctx; gemm_phase(g, lds); }
    XBAR();
    { KP p = get_params(); phase_norm(p, p->norm2_g + l * D, p->mods + (size_t)l * 3 * 6144, 3, 4, Mr, p->X, p->X + (size_t)TL * D); }
    XBAR();
#if PROBE_DUP == 2
    { KP p = get_params(); GemmArgs g; g.A = p->H; g.Bt = p->Wgu_t + (size_t)l * 2 * FFH * D; g.M = Mr; g.N = 2 * FFH; g.K = D; g.ctx = 0; g.mode = 2; g.Ob = p->P; g.X = nullptr; g.gate = nullptr; g.rope = nullptr; g.Xlat = nullptr; g.Xctx = nullptr; gemm_phase(g, lds); }
    XBAR();
#endif
    { KP p = get_params(); GemmArgs g; g.A = p->H; g.Bt = p->Wgu_t + (size_t)l * 2 * FFH * D; g.M = Mr; g.N = 2 * FFH; g.K = D; g.ctx = 0; g.mode = 2; g.Ob = p->P; g.X = nullptr; g.gate = nullptr; g.rope = nullptr; g.Xlat = nullptr; g.Xctx = nullptr; gemm_phase(g, lds); }
    XBAR();
#if PROBE_DUP == 2
    { KP p = get_params(); GemmArgs g; g.A = p->P; g.Bt = p->Wdown_t + (size_t)l * D * FFH; g.M = Mr; g.N = D; g.K = FFH; g.ctx = 0; g.mode = 0; g.Ob = p->MIX; g.X = nullptr; g.gate = nullptr; g.rope = nullptr; g.Xlat = nullptr; g.Xctx = nullptr; gemm_phase(g, lds); }
    XBAR();
#endif
    { KP p = get_params(); GemmArgs g; g.A = p->P; g.Bt = p->Wdown_t + (size_t)l * D * FFH; g.M = TL; g.ctx = !last; g.N = D; g.K = FFH; g.mode = 1; g.Ob = nullptr; g.X = p->X; g.gate = p->mods + (size_t)l * 3 * 6144 + 5 * 1024; g.rope = nullptr; g.Xlat = p->X; g.Xctx = p->X + (size_t)TL * D; gemm_phase(g, lds); }
    XBAR();
  }
  phase_final(get_params());
}

extern "C" void kernel_launch(void* const* d_in, const int* in_sizes, int n_in, void* d_out, int out_size, void* d_ws, size_t ws_size, hipStream_t stream) {
  static int grid_blocks = 0;
  if (!grid_blocks) {
    int dev = 0, cus = 0, per_cu = 0;
    hipGetDevice(&dev);
    hipDeviceGetAttribute(&cus, hipDeviceAttributeMultiprocessorCount, dev);
    hipFuncSetAttribute((const void*)mega, hipFuncAttributeMaxDynamicSharedMemorySize, LDS_BYTES);
    hipOccupancyMaxActiveBlocksPerMultiprocessor(&per_cu, (const void*)mega, NT, LDS_BYTES);
    if (per_cu < 1) per_cu = 1;
    grid_blocks = cus * per_cu;
  }
  Params p{};
  const float* const* in = (const float* const*)d_in;
  p.x = in[0]; p.c = in[1]; p.ctx = in[2]; p.c_ctx = in[3]; p.w_mod = in[4]; p.b_mod = in[5]; p.norm1_g = in[6]; p.norm2_g = in[7]; p.w_in = in[8];
  p.conv_w = in[9]; p.conv_b = in[10]; p.lru_wa = in[11]; p.lru_ba = in[12]; p.lru_wx = in[13]; p.lru_bx = in[14]; p.lru_lam = in[15]; p.diff_lam = in[16];
  p.subln_g = in[17]; p.rpb = in[18]; p.w_out = in[19]; p.w_gu = in[20]; p.w_down = in[21]; p.final_g = in[22];
  p.out = (float*)d_out;
  char* ws = (char*)d_ws; size_t off = 0;
  auto take = [&](size_t bytes) { char* q = ws + off; off += (bytes + 255) & ~(size_t)255; return q; };
  p.Win_t = (bf16_t*)take((size_t)DEPTH * INC * D * 2);
  p.Wout_t = (bf16_t*)take((size_t)DEPTH * D * D * 2);
  p.Wgu_t = (bf16_t*)take((size_t)DEPTH * 2 * FFH * D * 2);
  p.Wdown_t = (bf16_t*)take((size_t)DEPTH * D * FFH * 2);
  p.Wl = (bf16_t*)take((size_t)64 * 4096 * 2);
  p.X = (float*)take((size_t)T * D * 4);
  p.H = (bf16_t*)take((size_t)T * D * 2);
  p.P = (bf16_t*)take((size_t)T * INC * 2);
  p.MIX = (bf16_t*)take((size_t)T * D * 2);
  p.Vtd = (bf16_t*)take((size_t)NBATCH * 4 * 128 * NKEY * 2);
  p.Vtn = (bf16_t*)take((size_t)NBATCH * 4 * 64 * NKEY * 2);
  p.mods = (float*)take((size_t)DEPTH * 3 * 6144 * 4);
  p.rope = (float*)take((size_t)128 * 16 * 2 * 4);
  p.aggS = (float*)take((size_t)66 * 8 * 2 * 256 * 2 * 4);
  p.aggG = (float*)take((size_t)66 * 2 * 256 * 2 * 4);
  p.bar = (unsigned*)take((size_t)XCD_BAR_WORDS * 4);
  if (off > ws_size) { fprintf(stderr, "kernel_launch: workspace too small: need %zu have %zu\n", off, ws_size); return; }
  if (hipMemsetAsync(p.bar, 0, (size_t)XCD_BAR_WORDS * 4, stream) != hipSuccess) { fprintf(stderr, "kernel_launch: memset of barrier words failed\n"); return; }
  void* args[] = {&p};
  hipError_t e = hipLaunchCooperativeKernel((void*)mega, dim3(grid_blocks), dim3(NT), args, LDS_BYTES, stream);
  if (e != hipSuccess) fprintf(stderr, "cooperative launch failed: %s (grid %d)\n", hipGetErrorString(e), grid_blocks);
}
```

```cpp
#include <hip/hip_runtime.h>
#include <hip/hip_cooperative_groups.h>
#include <cstdio>
#include <cstdint>
namespace cg = cooperative_groups;
#ifndef PROBE_DUP
#define PROBE_DUP 0
#endif

typedef unsigned short bf16_t;
typedef short bf16x8 __attribute__((ext_vector_type(8)));
typedef float f32x4 __attribute__((ext_vector_type(4)));
typedef float f32x16 __attribute__((ext_vector_type(16)));
typedef unsigned u32x4 __attribute__((ext_vector_type(4)));
typedef unsigned u32x2 __attribute__((ext_vector_type(2)));

#define DI __device__ __forceinline__
#define MFMA32(a, b, c) __builtin_amdgcn_mfma_f32_32x32x16_bf16((a), (b), (c), 0, 0, 0)
#define MFMA16(a, b, c) __builtin_amdgcn_mfma_f32_16x16x32_bf16((a), (b), (c), 0, 0, 0)

constexpr int D = 1024, SEQ = 8192, NBATCH = 2, DEPTH = 4, CTXL = 256;
constexpr int TL = NBATCH * SEQ, TC = NBATCH * CTXL, T = TL + TC;
constexpr int INC = 2816, FFH = 2816, NKEY = CTXL + SEQ;
constexpr int LDS_BYTES = 131072 + 16;
constexpr int LDS_CONST = 122880;
constexpr int NT = 512;

struct Params {
  const float *x, *c, *ctx, *c_ctx, *w_mod, *b_mod, *norm1_g, *norm2_g, *w_in, *conv_w, *conv_b, *lru_wa, *lru_ba, *lru_wx, *lru_bx,
      *lru_lam, *diff_lam, *subln_g, *rpb, *w_out, *w_gu, *w_down, *final_g;
  float* out;
  bf16_t *Win_t, *Wout_t, *Wgu_t, *Wdown_t, *Wl;
  float* X;
  bf16_t *H, *P, *MIX, *Vtd, *Vtn;
  float *mods, *rope, *aggS, *aggG;
  unsigned* bar;
};

typedef const __attribute__((address_space(4))) Params* KP;
DI KP get_params() { KP kp = (KP)__builtin_amdgcn_kernarg_segment_ptr(); asm volatile("" : "+s"(kp)); return kp; }

#define XB_TMO      128
#define XB_XCNT(j)  (256  + 64 * (j))
#define XB_XSUB(j)  (1280 + 64 * (j))
#define XB_XGEN(j)  (2304 + 64 * (j))
#define XB_TOP      3328
#define XB_TOPGEN   3392
#define XCD_BAR_WORDS 3456
#define XB_SPIN_CAP (1u << 22)
#define LAS __attribute__((address_space(3)))
DI unsigned xb_ld(unsigned* p)              { return __hip_atomic_load(p, __ATOMIC_RELAXED, __HIP_MEMORY_SCOPE_AGENT); }
DI unsigned xb_add(unsigned* p, unsigned v) { return __hip_atomic_fetch_add(p, v, __ATOMIC_RELAXED, __HIP_MEMORY_SCOPE_AGENT); }
DI unsigned xb_xcc_id() { return (unsigned)__builtin_amdgcn_s_getreg((3 << 11) | 20) & 0xFu; }
#define XB_SPIN(cond, bar) do { unsigned _sp = 0; while (cond) { __builtin_amdgcn_s_sleep(1); \
    if ((++_sp & 255u) == 0u) { if (xb_ld(&(bar)[XB_TMO])) break; if (_sp > XB_SPIN_CAP) { atomicAdd(&(bar)[XB_TMO], 1u); break; } } } } while (0)
struct XcdBarrier { unsigned* bar; unsigned x; volatile LAS unsigned* st; };
DI XcdBarrier xcd_barrier_post(unsigned* bar, volatile LAS unsigned* st) {
  XcdBarrier b; b.bar = bar; b.x = xb_xcc_id(); b.st = st;
  if (threadIdx.x == 0) (void)xb_add(&bar[XB_XCNT(b.x)], 1u);
  return b;
}
DI void xcd_barrier_complete(unsigned* bar, unsigned x, unsigned& nloc, unsigned& nx) {
  const unsigned G = gridDim.x * gridDim.y * gridDim.z;
  unsigned sum, cnt, mine, sp = 0u;
  for (;;) {
    sum = 0u; cnt = 0u; mine = 0u;
#pragma unroll
    for (unsigned j = 0; j < 16; ++j) { const unsigned c = xb_ld(&bar[XB_XCNT(j)]); sum += c; cnt += (c > 0u) ? 1u : 0u; mine = (j == x) ? c : mine; }
    if (sum == G) break;
    __builtin_amdgcn_s_sleep(1);
    if ((++sp & 255u) == 0u) { if (xb_ld(&bar[XB_TMO])) break; if (sp > XB_SPIN_CAP) { atomicAdd(&bar[XB_TMO], 1u); break; } }
  }
  nloc = mine > 0u ? mine : 1u; nx = cnt > 0u ? cnt : 1u;
}
DI void xcd_barrier(const XcdBarrier& b) {
  asm volatile("s_waitcnt vmcnt(0)" ::: "memory");
  __syncthreads();
  if (threadIdx.x == 0) {
    unsigned* bar = b.bar;
    __builtin_amdgcn_s_waitcnt(0);
    unsigned nloc = b.st[0], nx = b.st[1];
    if (nloc == 0u) { xcd_barrier_complete(bar, b.x, nloc, nx); b.st[0] = nloc; b.st[1] = nx; }
    const unsigned old = xb_add(&bar[XB_XSUB(b.x)], 1u);
    const unsigned gen = old / nloc;
    if (old + 1u == (gen + 1u) * nloc) {
      __builtin_amdgcn_fence(__ATOMIC_RELEASE, "agent");
      asm volatile("s_waitcnt vmcnt(0)" ::: "memory");
      const unsigned og = xb_add(&bar[XB_TOP], 1u);
      const unsigned tg = og / nx;
      if (og + 1u == (tg + 1u) * nx) xb_add(&bar[XB_TOPGEN], 1u);
      else XB_SPIN(xb_ld(&bar[XB_TOPGEN]) == tg, bar);
      __builtin_amdgcn_fence(__ATOMIC_ACQUIRE, "agent");
      xb_add(&bar[XB_XGEN(b.x)], 1u);
      asm volatile("s_waitcnt vmcnt(0)" ::: "memory");
    } else {
      XB_SPIN(xb_ld(&bar[XB_XGEN(b.x)]) == gen, bar);
      __builtin_amdgcn_fence(__ATOMIC_ACQUIRE, "agent");
      asm volatile("s_waitcnt vmcnt(0)" ::: "memory");
    }
  }
  __syncthreads();
}

DI int tid_() { int t = threadIdx.x; asm volatile("" : "+v"(t)); return t; }
DI int bid_() { int b = blockIdx.x; asm volatile("" : "+s"(b)); return b; }
DI int gdim_() { int g = gridDim.x; asm volatile("" : "+s"(g)); return g; }

DI unsigned f2bf(float x) { unsigned u = __float_as_uint(x); u += 0x7fffu + ((u >> 16) & 1u); return u >> 16; }
typedef __bf16 bf16v2_t __attribute__((ext_vector_type(2)));
typedef float f32x2 __attribute__((ext_vector_type(2)));
DI unsigned pk2(float lo, float hi) { f32x2 v = {lo, hi}; bf16v2_t b = __builtin_convertvector(v, bf16v2_t); return __builtin_bit_cast(unsigned, b); }
DI float bf2f(bf16_t v) { return __uint_as_float(((unsigned)v) << 16); }
DI float wave_sum(float v) {
#pragma unroll
  for (int o = 1; o < 64; o <<= 1) v += __shfl_xor(v, o);
  return v;
}
DI float xhalf_max(float v) { const auto r = __builtin_amdgcn_permlane32_swap(__float_as_uint(v), __float_as_uint(v), false, false); return fmaxf(__uint_as_float(r[0]), __uint_as_float(r[1])); }
DI float sigmoidf_(float x) { return __builtin_amdgcn_rcpf(1.f + __expf(-x)); }
DI float gelu_tanh(float x) { const float u = 0.7978845608028654f * (x + 0.044715f * x * x * x); return 0.5f * x * (1.f + tanhf(u)); }

DI void wt_unit(const float* W, int K, int N, bf16_t* WT, int kt, int ntile, bool gu, float* scr  ) {
  const int tid = tid_(), k0 = kt * 64, n0 = ntile * 128;
  __syncthreads();
  {
    const int n = tid & 127, kq = tid >> 7;
#pragma unroll 4
    for (int i = 0; i < 16; ++i) { const int k = kq * 16 + i; scr[k * 129 + n] = W[(size_t)(k0 + k) * N + n0 + n]; }
  }
  __syncthreads();
  {
    const int n = tid >> 2, kq = tid & 3;
    const float* s = scr + (kq * 16) * 129 + n;
    u32x4 o0, o1;
    o0.x = pk2(s[0 * 129], s[1 * 129]); o0.y = pk2(s[2 * 129], s[3 * 129]); o0.z = pk2(s[4 * 129], s[5 * 129]); o0.w = pk2(s[6 * 129], s[7 * 129]);
    o1.x = pk2(s[8 * 129], s[9 * 129]); o1.y = pk2(s[10 * 129], s[11 * 129]); o1.z = pk2(s[12 * 129], s[13 * 129]); o1.w = pk2(s[14 * 129], s[15 * 129]);
    const int nsrc = n0 + n;
    int ndst = nsrc;
    if (gu) { const int sel = nsrc < FFH ? 0 : 1; const int j = nsrc - sel * FFH; ndst = (j >> 4) * 32 + sel * 16 + (j & 15); }
    bf16_t* d = WT + (size_t)ndst * K + k0 + kq * 16;
    *(u32x4*)d = o0; *(u32x4*)(d + 8) = o1;
  }
}

DI void mods_unit(KP p, int l, int cb, float* lds) {
  const int tid = tid_();
  float* cond = lds;
  float* red = lds + 3072;
  __syncthreads();
  for (int i = tid; i < 3072; i += NT) { const int v = i >> 10, k = i & 1023; const float c = v < 2 ? p->c[v * 1024 + k] : p->c_ctx[k]; cond[i] = c / (1.f + __expf(-c)); }
  __syncthreads();
  const int c4 = tid & 31, kg = tid >> 5;
  f32x4 a0 = {0.f, 0.f, 0.f, 0.f}, a1 = a0, a2 = a0;
  const float* w = p->w_mod + (size_t)l * 1024 * 6144 + cb * 128 + c4 * 4;
#pragma unroll 8
  for (int k = kg * 64; k < kg * 64 + 64; ++k) { const f32x4 wv = *(const f32x4*)(w + (size_t)k * 6144); a0 += wv * cond[k]; a1 += wv * cond[1024 + k]; a2 += wv * cond[2048 + k]; }
  *(f32x4*)(red + (kg * 3 + 0) * 128 + c4 * 4) = a0; *(f32x4*)(red + (kg * 3 + 1) * 128 + c4 * 4) = a1; *(f32x4*)(red + (kg * 3 + 2) * 128 + c4 * 4) = a2;
  __syncthreads();
  if (tid < 384) {
    const int v = tid >> 7, c2 = tid & 127;
    float s_ = 0.f;
#pragma unroll
    for (int q = 0; q < 16; ++q) s_ += red[(q * 3 + v) * 128 + c2];
    p->mods[(size_t)(l * 3 + v) * 6144 + cb * 128 + c2] = s_ + p->b_mod[l * 6144 + cb * 128 + c2];
  }
}

DI void phase_prologue(KP p, char* ldsc) {
  const int tid = tid_(), nb = gdim_(), bid = bid_();
  float* lds = (float*)ldsc;
  constexpr int U_MODS = DEPTH * 48, U_IN = 16 * 22, U_OUT = 16 * 8, U_GU = 16 * 44, U_DN = 44 * 8, U_WL = U_IN + U_OUT + U_GU + U_DN;
  constexpr int U_TOTAL = U_MODS + DEPTH * U_WL + 64 + 1;
  for (int u = bid; u < U_TOTAL; u += nb) {
    int r = u;
    if (r < U_MODS) { mods_unit(p, r / 48, r % 48, lds); continue; }
    r -= U_MODS;
    if (r < DEPTH * U_WL) {
      const int l = r / U_WL; r -= l * U_WL;
      if (r < U_IN) { wt_unit(p->w_in + (size_t)l * D * INC, D, INC, p->Win_t + (size_t)l * INC * D, r / 22, r % 22, false, lds); continue; }
      r -= U_IN;
      if (r < U_OUT) { wt_unit(p->w_out + (size_t)l * D * D, D, D, p->Wout_t + (size_t)l * D * D, r / 8, r % 8, false, lds); continue; }
      r -= U_OUT;
      if (r < U_GU) { wt_unit(p->w_gu + (size_t)l * D * 2 * FFH, D, 2 * FFH, p->Wgu_t + (size_t)l * 2 * FFH * D, r / 44, r % 44, true, lds); continue; }
      r -= U_GU;
      wt_unit(p->w_down + (size_t)l * FFH * D, FFH, D, p->Wdown_t + (size_t)l * D * FFH, r / 8, r % 8, false, lds);
      continue;
    }
    r -= DEPTH * U_WL;
    if (r < 64) {
      const int l = r >> 4, n = (r >> 2) & 3, dir = (r >> 1) & 1, kind = r & 1;
      const float* src = (kind ? p->lru_wx : p->lru_wa) + (size_t)((l * 2 + dir) * 4 + n) * 4096;
      bf16_t* dst = p->Wl + (size_t)r * 4096;
      for (int e = tid; e < 4096; e += NT) { const int j = e >> 6, i = e & 63; dst[j * 64 + i] = (bf16_t)f2bf(src[i * 64 + j]); }
      continue;
    }
    for (int e = tid; e < 128 * 16; e += NT) {
      const int pos = e >> 4, i = e & 15;
      const float inv = 1.0f / powf(10000.0f, (float)(2 * i) / 32.0f);
      const float ang = (float)pos * inv;
      p->rope[e * 2] = cosf(ang); p->rope[e * 2 + 1] = sinf(ang);
    }
  }
}

DI void phase_norm(KP p, const float* g, const float* mods_l, int shift_idx, int scale_idx, int nrows, const float* xlat, const float* xctx) {
  const int lane = tid_() & 63, gw = bid_() * 8 + (tid_() >> 6), ngw = gdim_() * 8;
  constexpr int R = 3;
#pragma unroll 1
  for (int row0 = gw; row0 < nrows; row0 += R * ngw) {
    f32x4 v[R][4]; float ss[R];
#pragma unroll
    for (int r = 0; r < R; ++r) {
      const int row = min(row0 + r * ngw, nrows - 1);
      const float* xr = row < TL ? xlat + (size_t)row * D : xctx + (size_t)(row - TL) * D;
#pragma unroll
      for (int j = 0; j < 4; ++j) v[r][j] = *(const f32x4*)(xr + j * 256 + lane * 4);
    }
#pragma unroll
    for (int r = 0; r < R; ++r) {
      float s_ = 0.f;
#pragma unroll
      for (int j = 0; j < 4; ++j) s_ += (v[r][j].x * v[r][j].x + v[r][j].y * v[r][j].y) + (v[r][j].z * v[r][j].z + v[r][j].w * v[r][j].w);
      ss[r] = wave_sum(s_);
    }
#pragma unroll
    for (int r = 0; r < R; ++r) {
      const int row = row0 + r * ngw;
      if (row < nrows) {
        const float rstd = 1.0f / sqrtf(ss[r] * (1.0f / D) + 1e-6f);
        const int vs = row < SEQ ? 0 : (row < TL ? 1 : 2);
        const float* sh = mods_l + vs * 6144 + shift_idx * 1024;
        const float* sc = mods_l + vs * 6144 + scale_idx * 1024;
        bf16_t* hr = p->H + (size_t)row * D;
#pragma unroll
        for (int j = 0; j < 4; ++j) {
          const int c = j * 256 + lane * 4;
          const f32x4 gv = *(const f32x4*)(g + c), shv = *(const f32x4*)(sh + c), scv = *(const f32x4*)(sc + c);
          const f32x4 h = v[r][j] * rstd * gv * (scv + 1.0f) + shv;
          u32x2 o; o.x = pk2(h.x, h.y); o.y = pk2(h.z, h.w);
          *(u32x2*)(hr + c) = o;
        }
      }
    }
  }
}

DI void phase_final(KP p) {
  const int lane = tid_() & 63, gw = bid_() * 8 + (tid_() >> 6), ngw = gdim_() * 8;
  constexpr int R = 4;
#pragma unroll 1
  for (int row0 = gw; row0 < TL; row0 += R * ngw) {
    f32x4 v[R][4]; float ss[R];
#pragma unroll
    for (int r = 0; r < R; ++r) {
      const int row = min(row0 + r * ngw, TL - 1);
      const float* xr = p->X + (size_t)row * D;
#pragma unroll
      for (int j = 0; j < 4; ++j) v[r][j] = *(const f32x4*)(xr + j * 256 + lane * 4);
    }
#pragma unroll
    for (int r = 0; r < R; ++r) {
      float s_ = 0.f;
#pragma unroll
      for (int j = 0; j < 4; ++j) s_ += (v[r][j].x * v[r][j].x + v[r][j].y * v[r][j].y) + (v[r][j].z * v[r][j].z + v[r][j].w * v[r][j].w);
      ss[r] = wave_sum(s_);
    }
#pragma unroll
    for (int r = 0; r < R; ++r) {
      const int row = row0 + r * ngw;
      if (row < TL) {
        const float rstd = 1.0f / sqrtf(ss[r] * (1.0f / D) + 1e-6f);
        float* orow = p->out + (size_t)row * D;
#pragma unroll
        for (int j = 0; j < 4; ++j) { const int c = j * 256 + lane * 4; const f32x4 gv = *(const f32x4*)(p->final_g + c); *(f32x4*)(orow + c) = v[r][j] * rstd * gv; }
      }
    }
  }
}

constexpr int BM = 256, BK = 64, HALF = 128, HT = HALF * BK;
DI int lds_byte(int r, int c) { const int st = (r >> 4) * 2 + (c >> 5), rr = r & 15, cc = c & 31, ob = rr * 64 + cc * 2; return st * 1024 + (ob ^ (((ob >> 9) & 1) << 5)); }
DI void stage_rc(int b, int& R, int& C) { const int st = b / 1024, sb = b % 1024, swz = sb ^ (((sb >> 9) & 1) << 5); R = (st >> 1) * 16 + swz / 64; C = (st & 1) * 32 + (swz % 64) / 2; }

struct GemmArgs { const bf16_t* A; const bf16_t* Bt; int M, N, K, mode; bf16_t* Ob; float* X; const float* gate; const float* rope; int ctx; const float* Xlat; const float* Xctx; };

DI void gemm_phase(const GemmArgs& g, char* shm_c) {
  typedef __attribute__((address_space(3))) unsigned char lds_u8;
  lds_u8* lds = (lds_u8*)shm_c;
  const int K = g.K;
  const int tid = tid_(), wid = __builtin_amdgcn_readfirstlane(tid >> 6), lane = tid & 63, wr = wid >> 2, wc = wid & 3, fr = lane & 15, fq = lane >> 4;
  unsigned voff[2];
#pragma unroll
  for (int i = 0; i < 2; ++i) { int R, C; stage_rc(tid * 16 + i * 8192, R, C); voff[i] = (unsigned)(R * K + C) * 2u; }
  const size_t kstep = (size_t)(BK * 2), hstep = (size_t)HALF * K * 2, tstep = 2 * hstep;
  const unsigned ldsw = (unsigned)wid * 1024u;
  const int aoff = lds_byte(wr * 64 + fr, fq * 8), boff = lds_byte(wc * 32 + fr, fq * 8);
#define SA(b, h) (((b) * 2 + (h)) * (HT * 2))
#define SB(b, h) ((4 + (b) * 2 + (h)) * (HT * 2))
#define STAGE(bufoff, gbase) do { _Pragma("unroll") for (int _i = 0; _i < 2; ++_i) \
    __builtin_amdgcn_global_load_lds((const unsigned*)((const char*)(gbase) + voff[_i]), (__attribute__((address_space(3))) unsigned*)(lds + (bufoff) + ldsw + _i * 8192), 16, 0, 0); } while (0)
#define LDA(dst, b, h) do { _Pragma("unroll") for (int m = 0; m < 4; ++m) _Pragma("unroll") for (int k = 0; k < 2; ++k) dst[m][k] = *(const __attribute__((address_space(3))) bf16x8*)(lds + SA(b, h) + aoff + m * 2048 + k * 1024); } while (0)
#define LDB(dst, b, h) do { _Pragma("unroll") for (int n = 0; n < 2; ++n) _Pragma("unroll") for (int k = 0; k < 2; ++k) dst[n][k] = *(const __attribute__((address_space(3))) bf16x8*)(lds + SB(b, h) + boff + n * 2048 + k * 1024); } while (0)
#define MMA(ai, bj, At_, Bt_) do { __builtin_amdgcn_s_setprio(1); \
    _Pragma("unroll") for (int m = 0; m < 4; ++m) _Pragma("unroll") for (int n = 0; n < 2; ++n) _Pragma("unroll") for (int k = 0; k < 2; ++k) \
      acc[ai][bj][m][n] = MFMA16(Bt_[n][k], At_[m][k], acc[ai][bj][m][n]); \
    __builtin_amdgcn_s_setprio(0); } while (0)
#define WAIT_V(n) asm volatile("s_waitcnt vmcnt(" #n ")" ::: "memory")
#define WAIT_L(n) asm volatile("s_waitcnt lgkmcnt(" #n ")" ::: "memory")
#define BAR __builtin_amdgcn_s_barrier()
#define SCHED __builtin_amdgcn_sched_barrier(0)
  const int nM = g.M / BM, nN = g.N / BM, ntiles = nM * nN;
  const int nt = K / BK;
#define TILE_PMPN(tile_, pm_, pn_) do { int wgid = (tile_); const int q = ntiles / 8, rr = ntiles % 8, xcd = wgid % 8, off = wgid / 8; \
    wgid = (xcd < rr ? xcd * (q + 1) : rr * (q + 1) + (xcd - rr) * q) + off; \
    const int nig = 8 * nN, gid = wgid / nig, fm = gid * 8, gsz = (nM - fm) < 8 ? (nM - fm) : 8; \
    pm_ = fm + ((wgid % nig) % gsz); pn_ = (wgid % nig) / gsz; } while (0)
#define PRO_ISSUE(cA_, cB_) do { STAGE(SB(0, 0), cB_); STAGE(SA(0, 0), cA_); STAGE(SB(0, 1), (cB_) + hstep); STAGE(SA(0, 1), (cA_) + hstep); \
    STAGE(SB(1, 0), (cB_) + kstep); STAGE(SA(1, 0), (cA_) + kstep); STAGE(SB(1, 1), (cB_) + hstep + kstep); } while (0)
  const int gstep = gdim_();
  int tile = bid_();
  int pm = 0, pn = 0;
  const char* cA = nullptr; const char* cB = nullptr;
  const bool has_work = tile < ntiles;
  f32x4 acc[2][2][4][2];
  bf16x8 At[4][2], B0[2][2], B1[2][2];
  if (has_work) {
    TILE_PMPN(tile, pm, pn); cA = (const char*)g.A + (size_t)pm * tstep; cB = (const char*)g.Bt + (size_t)pn * tstep;
#pragma unroll
    for (int a = 0; a < 2; ++a)
#pragma unroll
      for (int b = 0; b < 2; ++b)
#pragma unroll
        for (int m = 0; m < 4; ++m)
#pragma unroll
          for (int n = 0; n < 2; ++n) acc[a][b][m][n] = (f32x4){0.f, 0.f, 0.f, 0.f};
    STAGE(SB(0, 0), cB); STAGE(SB(0, 1), cB + hstep); STAGE(SA(0, 0), cA); STAGE(SA(0, 1), cA + hstep);
    if (wr == 1) BAR;
    WAIT_V(2); BAR;
    STAGE(SB(1, 0), cB + kstep); STAGE(SA(1, 0), cA + kstep); STAGE(SB(1, 1), cB + hstep + kstep);
    WAIT_V(6); BAR;
  }
#pragma unroll 1
  while (has_work) {
    const int brow = pm * BM, bcol = pn * BM;
    const int ntile = tile + gstep;
    const bool has_next = ntile < ntiles;
    int npm = pm, npn = pn;
    if (has_next) TILE_PMPN(ntile, npm, npn);
    const char* nA = (const char*)g.A + (size_t)npm * tstep; const char* nB = (const char*)g.Bt + (size_t)npn * tstep;
#pragma unroll 1
    for (int t = 0; t < nt; t += 2) {
      const bool last = t == nt - 2;
      const char* a1 = cA + (size_t)(t + 1) * kstep;
      const char* a2 = last ? nA : cA + (size_t)(t + 2) * kstep; const char* b2 = last ? nB : cB + (size_t)(t + 2) * kstep;
      const char* a3 = a2 + kstep; const char* b3 = b2 + kstep;
      LDB(B0, 0, 0); LDB(B1, 0, 1); SCHED; LDA(At, 0, 0); STAGE(SA(1, 1), a1 + hstep);
      WAIT_V(8); WAIT_L(0); BAR; MMA(0, 0, At, B0); MMA(0, 1, At, B1); BAR; SCHED;
      LDA(At, 0, 1); STAGE(SB(0, 0), b2); STAGE(SB(0, 1), b2 + hstep); STAGE(SA(0, 0), a2);
      WAIT_V(8); WAIT_L(0); BAR; MMA(1, 0, At, B0); MMA(1, 1, At, B1); BAR; SCHED;
      LDB(B0, 1, 0); LDB(B1, 1, 1); SCHED; LDA(At, 1, 0); STAGE(SA(0, 1), a2 + hstep);
      WAIT_V(8); WAIT_L(0); BAR; MMA(0, 0, At, B0); MMA(0, 1, At, B1); BAR; SCHED;
      LDA(At, 1, 1); STAGE(SB(1, 0), b3); STAGE(SB(1, 1), b3 + hstep); STAGE(SA(1, 0), a3);
      WAIT_V(8); WAIT_L(0); BAR; MMA(1, 0, At, B0); MMA(1, 1, At, B1); BAR; SCHED;
    }
    if (wr == 0) BAR;
    if (g.mode == 0) {
#pragma unroll
      for (int ai = 0; ai < 2; ++ai)
#pragma unroll
        for (int m = 0; m < 4; ++m) {
          const int row = brow + ai * HALF + wr * 64 + m * 16 + fr;
          bf16_t* rp0 = g.Ob + (size_t)row * g.N + bcol + wc * 32;
#pragma unroll
          for (int bj = 0; bj < 2; ++bj) {
            f32x4 v0 = acc[ai][bj][m][0], v1 = acc[ai][bj][m][1];
            const int gb = bcol + bj * HALF + wc * 32;
            if (g.rope != nullptr && gb >= 512 && gb < 1536 && brow < TL) {
              const int sq = row & (SEQ - 1), pos = (gb & 32) ? (sq & 63) : (sq >> 6);
              const float* rt = g.rope + (pos * 16 + 4 * fq) * 2;
              const f32x4 t0 = *(const f32x4*)rt, t1 = *(const f32x4*)(rt + 4);
              const f32x4 cs = {t0[0], t0[2], t1[0], t1[2]}, sn = {t0[1], t0[3], t1[1], t1[3]};
              const f32x4 r0 = v0 * cs - v1 * sn, r1 = v1 * cs + v0 * sn;
              v0 = r0; v1 = r1;
            }
            u32x2 a, b2; a.x = pk2(v0[0], v0[1]); a.y = pk2(v0[2], v0[3]); b2.x = pk2(v1[0], v1[1]); b2.y = pk2(v1[2], v1[3]);
            const auto sx = __builtin_amdgcn_permlane16_swap(a.x, b2.x, false, false);
            const auto sy = __builtin_amdgcn_permlane16_swap(a.y, b2.y, false, false);
            u32x4 w4; w4.x = sx[0]; w4.y = sy[0]; w4.z = sx[1]; w4.w = sy[1];
            *(u32x4*)(rp0 + bj * HALF + ((fq & 1) ? 16 + 4 * (fq - 1) : 4 * fq)) = w4;
          }
        }
    } else if (g.mode == 1) {
      const float* gp = g.gate + (brow < SEQ ? 0 : 1) * 6144 + bcol + wc * 32 + 4 * fq;
      f32x4 gvv[2][2];
#pragma unroll
      for (int bj = 0; bj < 2; ++bj)
#pragma unroll
        for (int n = 0; n < 2; ++n) gvv[bj][n] = *(const f32x4*)(gp + bj * HALF + n * 16);
#pragma unroll
      for (int ai = 0; ai < 2; ++ai)
#pragma unroll
        for (int m = 0; m < 4; ++m) {
          const int row = brow + ai * HALF + wr * 64 + m * 16 + fr;
          float* rp = g.X + (size_t)row * g.N + bcol + wc * 32 + 4 * fq;
          const float* rin = g.Xlat + (size_t)row * g.N + bcol + wc * 32 + 4 * fq;
#pragma unroll
          for (int bj = 0; bj < 2; ++bj)
#pragma unroll
            for (int n = 0; n < 2; ++n) {
              f32x4 xv = *(const f32x4*)(rin + bj * HALF + n * 16);
              xv += gvv[bj][n] * acc[ai][bj][m][n];
              *(f32x4*)(rp + bj * HALF + n * 16) = xv;
            }
        }
    } else {
      const int ldo = g.N >> 1;
#pragma unroll
      for (int ai = 0; ai < 2; ++ai)
#pragma unroll
        for (int m = 0; m < 4; ++m) {
          const int row = brow + ai * HALF + wr * 64 + m * 16 + fr;
          bf16_t* rp0 = g.Ob + (size_t)row * ldo + ((bcol + wc * 32) >> 1);
          u32x2 ob[2];
#pragma unroll
          for (int bj = 0; bj < 2; ++bj) {
            const f32x4 gg = acc[ai][bj][m][0], uu = acc[ai][bj][m][1];
            f32x4 r;
#pragma unroll
            for (int j = 0; j < 4; ++j) r[j] = gg[j] * sigmoidf_(gg[j]) * uu[j];
            ob[bj].x = pk2(r[0], r[1]); ob[bj].y = pk2(r[2], r[3]);
          }
          const auto sx = __builtin_amdgcn_permlane16_swap(ob[0].x, ob[1].x, false, false);
          const auto sy = __builtin_amdgcn_permlane16_swap(ob[0].y, ob[1].y, false, false);
          u32x4 w4; w4.x = sx[0]; w4.y = sy[0]; w4.z = sx[1]; w4.w = sy[1];
          *(u32x4*)(rp0 + ((fq & 1) ? HALF / 2 + 4 * (fq - 1) : 4 * fq)) = w4;
        }
    }
    if (!has_next) break;
#pragma unroll
    for (int a = 0; a < 2; ++a)
#pragma unroll
      for (int b = 0; b < 2; ++b)
#pragma unroll
        for (int m = 0; m < 4; ++m)
#pragma unroll
          for (int n = 0; n < 2; ++n) acc[a][b][m][n] = (f32x4){0.f, 0.f, 0.f, 0.f};
    tile = ntile; pm = npm; pn = npn; cA = nA; cB = nB;
    if (wr == 1) BAR;
  }
  if (has_work) {
    WAIT_V(0);
    BAR;
  }
  if (g.mode == 1 && g.ctx) {
    bf16_t* sAm = (bf16_t*)shm_c;
    bf16_t* sBm = sAm + 32 * 520;
#pragma unroll 1
    for (int piece = bid_(); piece < 256; piece += gstep) {
      const int rb = piece >> 4, cb = piece & 15, mt = wid >> 2, ntl = wid & 3;
      const bf16_t* Ag = g.A + (size_t)(TL + rb * 32) * K;
      const bf16_t* Bg = g.Bt + (size_t)(cb * 64) * K;
      const int prow = tid >> 6, pc = tid & 63;
      f32x4 c4 = {0.f, 0.f, 0.f, 0.f};
      u32x4 ra[4], rbv[8];
#define MLOAD(k0_) do { const int cw_ = (K - (k0_)) < 512 ? (K - (k0_)) : 512; if (pc * 8 < cw_) { \
        _Pragma("unroll") for (int u = 0; u < 4; ++u) ra[u] = *(const u32x4*)(Ag + (size_t)(prow + 8 * u) * K + (k0_) + pc * 8); \
        _Pragma("unroll") for (int u = 0; u < 8; ++u) rbv[u] = *(const u32x4*)(Bg + (size_t)(prow + 8 * u) * K + (k0_) + pc * 8); } } while (0)
      MLOAD(0);
#pragma unroll 1
      for (int k0 = 0; k0 < K; k0 += 512) {
        const int cw = (K - k0) < 512 ? (K - k0) : 512;
        __syncthreads();
        if (pc * 8 < cw) {
#pragma unroll
          for (int u = 0; u < 4; ++u) *(u32x4*)(sAm + (prow + 8 * u) * 520 + pc * 8) = ra[u];
#pragma unroll
          for (int u = 0; u < 8; ++u) *(u32x4*)(sBm + (prow + 8 * u) * 520 + pc * 8) = rbv[u];
        }
        __syncthreads();
        if (k0 + 512 < K) MLOAD(k0 + 512);
#pragma unroll 4
        for (int u = 0; u < cw / 32; ++u) {
          const bf16x8 av = *(const bf16x8*)(sAm + (mt * 16 + fr) * 520 + 32 * u + 8 * fq);
          const bf16x8 bv = *(const bf16x8*)(sBm + (ntl * 16 + fr) * 520 + 32 * u + 8 * fq);
          c4 = MFMA16(av, bv, c4);
        }
      }
#undef MLOAD
      const int col = cb * 64 + ntl * 16 + fr;
      const float gv = g.gate[2 * 6144 + col];
#pragma unroll
      for (int j = 0; j < 4; ++j) { const size_t ro = (size_t)(rb * 32 + mt * 16 + 4 * fq + j) * g.N + col; g.X[(size_t)TL * g.N + ro] = g.Xctx[ro] + gv * c4[j]; }
    }
    __syncthreads();
  }
#undef SA
#undef SB
#undef STAGE
#undef LDA
#undef LDB
#undef MMA
}

constexpr int LRU_WN = 0, LRU_CONST = 36864, LRU_CARRY = 38400, LRU_AGGW = 42496, LRU_PART = 50688, LRU_WAVE = 54784, LRU_WAVE_BYTES = 9216;

template <int MODE>
DI void lru_group_unit(KP p, int l, int g, int n, char* ldsc) {
  const int tid = tid_(), lane = tid & 63, w = __builtin_amdgcn_readfirstlane(tid >> 6), fr = lane & 15, fq = lane >> 4;
  bf16_t* Wn = (bf16_t*)(ldsc + LRU_WN);
  float* cst = (float*)(ldsc + LRU_CONST);
  float* carry = (float*)(ldsc + LRU_CARRY);
  float* aggw = (float*)(ldsc + LRU_AGGW);
  float* part = (float*)(ldsc + LRU_PART);
  bf16_t* xs = (bf16_t*)(ldsc + LRU_WAVE + w * LRU_WAVE_BYTES);
  bf16_t* xcb = xs + 36 * 64;
  const bool isctx = g >= 64;
  const int b = isctx ? g - 64 : g >> 5, gi = isctx ? 0 : g & 31;
  const int L = isctx ? CTXL : SEQ;
  const int row0 = g * 256 + w * 32;
  const int t0 = gi * 256 + w * 32;
  __syncthreads();
  {
    const bf16_t* Wg = p->Wl + (size_t)((l * 4 + n) * 4) * 4096;
#pragma unroll
    for (int u = 0; u < 4; ++u) { const int q = tid + NT * u, rowi = q >> 3, pc = q & 7;
      *(u32x4*)(Wn + rowi * 72 + pc * 8) = *(const u32x4*)(Wg + rowi * 64 + pc * 8); }
    if (tid < 128) { const int dir = tid >> 6, ch = tid & 63, gch = (l * 2 + dir) * 256 + n * 64 + ch;
      cst[tid * 3 + 0] = p->lru_ba[gch]; cst[tid * 3 + 1] = p->lru_bx[gch]; cst[tid * 3 + 2] = -8.0f * log1pf(expf(-p->lru_lam[gch])); }
    for (int q = lane; q < 35 * 8; q += 64) {
      const int tt = q >> 3, pc = q & 7, t = t0 + tt - 2;
      u32x4 v = {0u, 0u, 0u, 0u};
      if (t >= 0 && t < L) v = *(const u32x4*)(p->P + (size_t)(row0 + tt - 2) * INC + n * 64 + pc * 8);
      *(u32x4*)(xs + tt * 64 + pc * 8) = v;
    }
  }
  if (MODE == 1) {
    const int seg = tid >> 7, dir = (tid >> 6) & 1, ch = tid & 63, gch = n * 64 + ch;
    const int nch = isctx ? 0 : (dir == 0 ? 1 + gi : 32 - gi);
    float ca[8], cb[8];
#pragma unroll
    for (int e8 = 0; e8 < 8; ++e8) {
      const int e = seg * 8 + e8;
      const int ee = e < nch ? e : 0;
      const int gg = ee == 0 ? 64 + b : (dir == 0 ? b * 32 + (ee - 1) : b * 32 + 32 - ee);
      const float* q = p->aggG + ((size_t)(gg * 2 + dir) * 256 + gch) * 2;
      const float a_ = q[0], b_ = q[1];
      ca[e8] = e < nch ? a_ : 1.f; cb[e8] = e < nch ? b_ : 0.f;
    }
    float A = 1.f, B = 0.f;
#pragma unroll
    for (int e8 = 0; e8 < 8; ++e8) { B = ca[e8] * B + cb[e8]; A = A * ca[e8]; }
    part[((seg * 2 + dir) * 64 + ch) * 2 + 0] = A; part[((seg * 2 + dir) * 64 + ch) * 2 + 1] = B;
  }
  __syncthreads();
  {
    const int ch = lane;
    const float* cw = p->conv_w + l * 4 * 256 + n * 64 + ch;
    const float cb_ = p->conv_b[l * 256 + n * 64 + ch];
    const float w0 = cw[0], w1 = cw[256], w2 = cw[512], w3 = cw[768];
    float x0 = bf2f(xs[ch]), x1 = bf2f(xs[64 + ch]), x2 = bf2f(xs[128 + ch]);
#pragma unroll 8
    for (int t = 0; t < 32; ++t) {
      const float x3 = bf2f(xs[(t + 3) * 64 + ch]);
      const float y = cb_ + w0 * x0 + w1 * x1 + w2 * x2 + w3 * x3;
      xcb[t * 72 + ch] = (bf16_t)f2bf(y);
      x0 = x1; x1 = x2; x2 = x3;
    }
  }
  if (MODE == 1 && tid < 128) {
    const int dir = tid >> 6, ch = tid & 63, gch = n * 64 + ch;
    float h = 0.f;
#pragma unroll
    for (int sg = 0; sg < 4; ++sg) h = part[((sg * 2 + dir) * 64 + ch) * 2] * h + part[((sg * 2 + dir) * 64 + ch) * 2 + 1];
    float sa[8], sb[8];
#pragma unroll
    for (int w2 = 0; w2 < 8; ++w2) { const float* q = p->aggS + ((size_t)((g * 8 + w2) * 2 + dir) * 256 + gch) * 2; sa[w2] = q[0]; sb[w2] = q[1]; }
#pragma unroll
    for (int i = 0; i < 8; ++i) { const int w2 = dir == 0 ? i : 7 - i; carry[(w2 * 2 + dir) * 64 + ch] = h; h = sa[w2] * h + sb[w2]; }
  }
  __syncthreads();
  bf16x8 af[2][2];
#pragma unroll
  for (int m = 0; m < 2; ++m)
#pragma unroll
    for (int ks = 0; ks < 2; ++ks) af[m][ks] = *(const bf16x8*)(xcb + (16 * m + fr) * 72 + 32 * ks + 8 * fq);
  float hf[4][2][4];
#pragma unroll
  for (int dir = 0; dir < 2; ++dir)
#pragma unroll
    for (int cg = 0; cg < 4; ++cg) {
      const int ch = cg * 16 + fr;
      float gl[2][4];
      if (MODE == 1 && dir == 1) {
#pragma unroll
        for (int m = 0; m < 2; ++m)
#pragma unroll
          for (int j = 0; j < 4; ++j) gl[m][j] = bf2f(p->P[(size_t)(row0 + 16 * m + 4 * fq + j) * INC + 256 + n * 64 + ch]);
      }
      bf16x8 bfr[2][2];
#pragma unroll
      for (int kind = 0; kind < 2; ++kind)
#pragma unroll
        for (int ks = 0; ks < 2; ++ks) bfr[kind][ks] = *(const bf16x8*)(Wn + ((dir * 2 + kind) * 64 + ch) * 72 + 32 * ks + 8 * fq);
      f32x4 acc[2][2];
#pragma unroll
      for (int m = 0; m < 2; ++m)
#pragma unroll
        for (int kind = 0; kind < 2; ++kind) acc[m][kind] = (f32x4){0.f, 0.f, 0.f, 0.f};
#pragma unroll
      for (int m = 0; m < 2; ++m)
#pragma unroll
        for (int ks = 0; ks < 2; ++ks)
#pragma unroll
          for (int kind = 0; kind < 2; ++kind) acc[m][kind] = MFMA16(af[m][ks], bfr[kind][ks], acc[m][kind]);
      const float ba = cst[(dir * 64 + ch) * 3], bx = cst[(dir * 64 + ch) * 3 + 1], ls8 = cst[(dir * 64 + ch) * 3 + 2];
      float a[2][4], bb[2][4];
#pragma unroll
      for (int m = 0; m < 2; ++m)
#pragma unroll
        for (int j = 0; j < 4; ++j) {
          const int t = 16 * m + 4 * fq + j;
          const float r = sigmoidf_(acc[m][0][j] + ba), ig = sigmoidf_(acc[m][1][j] + bx);
          const float la = ls8 * r, x2 = 2.0f * la;
          a[m][j] = __expf(la);
          const float em = -x2 * (1.0f + x2 * (0.5f + x2 * (0.16666667f + x2 * (0.041666668f + x2 * 0.0083333338f))));
          bb[m][j] = __builtin_amdgcn_sqrtf(em) * (ig * bf2f(xcb[t * 72 + ch]));
        }
      float IA[2], IB[2], TA[2], TB[2];
      const int src1 = (dir == 0 ? lane - 16 : lane + 16) & 63, src2 = (dir == 0 ? lane - 32 : lane + 32) & 63;
      const bool v1 = dir == 0 ? fq >= 1 : fq <= 2, v2 = dir == 0 ? fq >= 2 : fq <= 1;
      const int lastl = dir == 0 ? fr + 48 : fr;
#pragma unroll
      for (int m = 0; m < 2; ++m) {
        float A = 1.f, B = 0.f;
#pragma unroll
        for (int jj = 0; jj < 4; ++jj) { const int j = dir == 0 ? jj : 3 - jj; B = a[m][j] * B + bb[m][j]; A = A * a[m][j]; }
        float ua = __shfl(A, src1), ub = __shfl(B, src1);
        if (v1) { B = A * ub + B; A = A * ua; }
        ua = __shfl(A, src2); ub = __shfl(B, src2);
        if (v2) { B = A * ub + B; A = A * ua; }
        IA[m] = A; IB[m] = B;
        TA[m] = __shfl(A, lastl); TB[m] = __shfl(B, lastl);
      }
      const int mf = dir == 0 ? 0 : 1, ms = 1 - mf;
      if (MODE == 0) {
        if (fq == 0) {
          const float A = TA[ms] * TA[mf], B = TA[ms] * TB[mf] + TB[ms];
          float* q = p->aggS + ((size_t)((g * 8 + w) * 2 + dir) * 256 + n * 64 + ch) * 2;
          q[0] = A; q[1] = B;
          aggw[((w * 2 + dir) * 64 + ch) * 2] = A; aggw[((w * 2 + dir) * 64 + ch) * 2 + 1] = B;
        }
      } else {
        const float c = carry[(w * 2 + dir) * 64 + ch];
#pragma unroll
        for (int mi = 0; mi < 2; ++mi) {
          const int m = mi == 0 ? mf : ms;
          const float hin = mi == 0 ? c : TA[mf] * c + TB[mf];
          float ea = __shfl(IA[m], src1), eb = __shfl(IB[m], src1);
          if (!v1) { ea = 1.f; eb = 0.f; }
          float h = ea * hin + eb;
#pragma unroll
          for (int jj = 0; jj < 4; ++jj) {
            const int j = dir == 0 ? jj : 3 - jj;
            h = a[m][j] * h + bb[m][j];
            if (dir == 0) hf[cg][m][j] = h;
            else {
              const float y = hf[cg][m][j] + h, gv = gl[m][j];
              const float u = 0.7978845608028654f * (gv + 0.044715f * gv * gv * gv);
              p->MIX[(size_t)(row0 + 16 * m + 4 * fq + j) * D + n * 64 + ch] = (bf16_t)f2bf(y * gv * sigmoidf_(2.0f * u));
            }
          }
        }
      }
    }
  if (MODE == 0) {
    __syncthreads();
    if (tid < 128) {
      const int dir = tid >> 6, ch = tid & 63;
      float A = 1.f, B = 0.f;
#pragma unroll
      for (int i = 0; i < 8; ++i) { const int w2 = dir == 0 ? i : 7 - i; const float a_ = aggw[((w2 * 2 + dir) * 64 + ch) * 2], b_ = aggw[((w2 * 2 + dir) * 64 + ch) * 2 + 1]; B = a_ * B + b_; A = A * a_; }
      float* q = p->aggG + ((size_t)(g * 2 + dir) * 256 + n * 64 + ch) * 2;
      q[0] = A; q[1] = B;
    }
  }
}

DI void phase_prep(KP p, int l, char* ldsc) {
  const int tid = tid_();
  constexpr int U_TR = 264 * 3, U_LRU = 66 * 4;
#pragma unroll 1
  for (int r = bid_(); r < U_LRU; r += gdim_()) lru_group_unit<0>(p, l, r >> 2, r & 3, ldsc);
#pragma unroll 1
  for (int r = bid_() - 8; r >= 0 && r < U_TR; r += gdim_() - 8) {
    {

      const int chunk = r / 3, cgp = r % 3;
      int row0, b, keypos;
      if (chunk < 256) { b = chunk >> 7; row0 = chunk * 64; keypos = CTXL + (chunk & 127) * 64; }
      else { const int cc = chunk - 256; b = cc >> 2; row0 = TL + cc * 64; keypos = (cc & 3) * 64; }
      const int colbase = cgp < 2 ? 1536 + cgp * 256 : 2560;
      bf16_t* Tt = (bf16_t*)ldsc;
      __syncthreads();
#pragma unroll
      for (int uu = 0; uu < 4; ++uu) {
        const int q = tid + NT * uu, rr = q >> 5, pc = q & 31;
        *(u32x4*)(Tt + rr * 264 + pc * 8) = *(const u32x4*)(p->P + (size_t)(row0 + rr) * INC + colbase + pc * 8);
      }
      __syncthreads();
#pragma unroll
      for (int uu = 0; uu < 4; ++uu) {
        const int q = tid + NT * uu, c = q >> 3, pk = q & 7;
        const bf16_t* s = Tt + (8 * pk) * 264 + c;
        u32x4 o;
        o.x = (unsigned)s[0] | ((unsigned)s[264] << 16); o.y = (unsigned)s[2 * 264] | ((unsigned)s[3 * 264] << 16);
        o.z = (unsigned)s[4 * 264] | ((unsigned)s[5 * 264] << 16); o.w = (unsigned)s[6 * 264] | ((unsigned)s[7 * 264] << 16);
        bf16_t* dst;
        if (cgp < 2) { const int h = cgp * 2 + (c >> 7), dv = c & 127; dst = p->Vtd + ((size_t)((b * 4 + h) * 128 + dv)) * NKEY + keypos + 8 * pk; }
        else { const int h = c >> 6, dv = c & 63; dst = p->Vtn + ((size_t)((b * 4 + h) * 64 + dv)) * NKEY + keypos + 8 * pk; }
        *(u32x4*)dst = o;
      }
    }
  }
}

constexpr float QK_C = 0.125f * 1.4426950408889634f;
constexpr float LOG2E = 1.4426950408889634f;

typedef __attribute__((address_space(3))) unsigned char lds_u8;
typedef __attribute__((address_space(3))) bf16x8 lds_bf16x8;
#define GLDS16(gp, lp) __builtin_amdgcn_global_load_lds((const unsigned*)(gp), (__attribute__((address_space(3))) unsigned*)(lp), 16, 0, 0)
template <int DV, bool LOCAL>
DI void attn_tile(const bf16x8 (&qf)[4], const lds_u8* Kb, const lds_u8* Vb, const int (&ko)[4], const int (&vo)[4], f32x16 (&o)[DV / 32], float& m, float& l, int hh,
                  const float* rpbs, int drow, int cq, int c0) {
  constexpr int ND = DV / 32;
#define ASCHED __builtin_amdgcn_sched_barrier(0)
  f32x16 st[2];
  {
    bf16x8 kf[2][4];
#pragma unroll
    for (int t = 0; t < 2; ++t)
#pragma unroll
      for (int ks = 0; ks < 4; ++ks) kf[t][ks] = *(const lds_bf16x8*)(Kb + ko[ks] + t * 4096);
    ASCHED;
#pragma unroll
    for (int t = 0; t < 2; ++t) {
      f32x16 s;
#pragma unroll
      for (int i = 0; i < 16; ++i) s[i] = 0.f;
#pragma unroll
      for (int ks = 0; ks < 4; ++ks) s = MFMA32(kf[t][ks], qf[ks], s);
      st[t] = s;
    }
  }
  bf16x8 va[2][ND];
#pragma unroll
  for (int s2 = 0; s2 < 2; ++s2)
#pragma unroll
    for (int d = 0; d < ND; ++d) va[s2][d] = *(const lds_bf16x8*)(Vb + vo[s2] + d * 4096);
  ASCHED;
  float mx = -3.0e38f;
  if (LOCAL) {
#pragma unroll
    for (int t = 0; t < 2; ++t)
#pragma unroll
      for (int i = 0; i < 16; ++i) {
        const int ck = 32 * t + 16 * (i >> 3) + 8 * hh + (i & 7);
        const int dc = ck - cq + 15;
        const bool ok = (ck >= c0) && (ck < c0 + 16);
        const int dcc = dc < 0 ? 0 : (dc > 30 ? 30 : dc);
        const float z = ok ? __builtin_fmaf(st[t][i], QK_C, rpbs[drow * 31 + dcc]) : -1.0e30f;
        st[t][i] = z; mx = fmaxf(mx, z);
      }
  } else {
#pragma unroll
    for (int t = 0; t < 2; ++t)
#pragma unroll
      for (int i = 0; i < 16; ++i) mx = fmaxf(mx, st[t][i]);
    mx *= QK_C;
  }
  mx = xhalf_max(mx);
  if (!__all(mx <= m + 8.0f)) {
    const float mn = fmaxf(m, mx);
    const float alpha = __builtin_amdgcn_exp2f(m - mn);
    m = mn; l *= alpha;
#pragma unroll
    for (int d = 0; d < ND; ++d) o[d] *= alpha;
  }
  float ps = 0.f;
#pragma unroll
  for (int t = 0; t < 2; ++t)
#pragma unroll
    for (int i = 0; i < 16; ++i) {
      const float pv = LOCAL ? __builtin_amdgcn_exp2f(st[t][i] - m) : __builtin_amdgcn_exp2f(__builtin_fmaf(st[t][i], QK_C, -m));
      st[t][i] = pv; ps += pv;
    }
  l += ps;
  ASCHED;
  bf16x8 vb[2][ND];
#pragma unroll
  for (int s2 = 0; s2 < 2; ++s2)
#pragma unroll
    for (int d = 0; d < ND; ++d) vb[s2][d] = *(const lds_bf16x8*)(Vb + vo[2 + s2] + d * 4096);
#pragma unroll
  for (int s2 = 0; s2 < 2; ++s2) {
    u32x4 pw;
    pw.x = pk2(st[0][8 * s2 + 0], st[0][8 * s2 + 1]); pw.y = pk2(st[0][8 * s2 + 2], st[0][8 * s2 + 3]);
    pw.z = pk2(st[0][8 * s2 + 4], st[0][8 * s2 + 5]); pw.w = pk2(st[0][8 * s2 + 6], st[0][8 * s2 + 7]);
    const bf16x8 pf = __builtin_bit_cast(bf16x8, pw);
#pragma unroll
    for (int d = 0; d < ND; ++d) o[d] = MFMA32(va[s2][d], pf, o[d]);
  }
  ASCHED;
#pragma unroll
  for (int s2 = 0; s2 < 2; ++s2) {
    u32x4 pw;
    pw.x = pk2(st[1][8 * s2 + 0], st[1][8 * s2 + 1]); pw.y = pk2(st[1][8 * s2 + 2], st[1][8 * s2 + 3]);
    pw.z = pk2(st[1][8 * s2 + 4], st[1][8 * s2 + 5]); pw.w = pk2(st[1][8 * s2 + 6], st[1][8 * s2 + 7]);
    const bf16x8 pf = __builtin_bit_cast(bf16x8, pw);
#pragma unroll
    for (int d = 0; d < ND; ++d) o[d] = MFMA32(vb[s2][d], pf, o[d]);
  }
#undef ASCHED
}

DI void qk_tile(const bf16x8 (&qf)[4], const lds_u8* Kb, const int (&ko)[4], f32x16 (&st)[2]) {
  bf16x8 kf[2][4];
#pragma unroll
  for (int t = 0; t < 2; ++t)
#pragma unroll
    for (int ks = 0; ks < 4; ++ks) kf[t][ks] = *(const lds_bf16x8*)(Kb + ko[ks] + t * 4096);
#pragma unroll
  for (int t = 0; t < 2; ++t) {
    f32x16 s;
#pragma unroll
    for (int i = 0; i < 16; ++i) s[i] = 0.f;
#pragma unroll
    for (int ks = 0; ks < 4; ++ks) s = MFMA32(kf[t][ks], qf[ks], s);
    st[t] = s;
  }
}
DI void pv_grp(f32x16 (&o)[4], const bf16x8 (&v)[4], const bf16x8& Pq) {
#pragma unroll
  for (int d = 0; d < 4; ++d) o[d] = MFMA32(v[d], Pq, o[d]);
}
template <int Q>
DI float exp_pack1(const f32x16 (&st)[2], float m, bf16x8& Pq) {
  float e[8]; float ps = 0.f;
#pragma unroll
  for (int j = 0; j < 8; ++j) { e[j] = __builtin_amdgcn_exp2f(__builtin_fmaf(st[Q >> 1][8 * (Q & 1) + j], QK_C, -m)); ps += e[j]; }
  u32x4 pw; pw.x = pk2(e[0], e[1]); pw.y = pk2(e[2], e[3]); pw.z = pk2(e[4], e[5]); pw.w = pk2(e[6], e[7]);
  Pq = __builtin_bit_cast(bf16x8, pw);
  return ps;
}
DI float exp_pack(const f32x16 (&st)[2], float m, bf16x8 (&Pn)[4]) {
  return (exp_pack1<0>(st, m, Pn[0]) + exp_pack1<1>(st, m, Pn[1])) + (exp_pack1<2>(st, m, Pn[2]) + exp_pack1<3>(st, m, Pn[3]));
}
DI float tile_max(const f32x16 (&st)[2]) {
  float mx = st[0][0];
#pragma unroll
  for (int t = 0; t < 2; ++t)
#pragma unroll
    for (int i = 0; i < 16; ++i) mx = fmaxf(mx, st[t][i]);
  mx *= QK_C;
  return xhalf_max(mx);
}

DI void diff_unit(KP p, int l, int b, int h, int qb, int isctx, float lamv, float lam_init, char* ldsc) {
  const int tid = tid_(), lane = tid & 63, w = __builtin_amdgcn_readfirstlane(tid >> 6), r = lane & 31, hh = lane >> 5;
  const int pr = (r & ~12) | ((r & 4) << 1) | ((r & 8) >> 1);
  const int comp = w & 1, grp = w >> 1;
  const int qrow = (isctx ? TL + b * CTXL : b * SEQ) + qb * 128 + grp * 32 + r;
  const int nt = isctx ? 4 : 132;
  lds_u8* L = (lds_u8*)ldsc;
  constexpr int STG = 32768;
  int ko[4], vo[4];
#pragma unroll
  for (int ks = 0; ks < 4; ++ks) ko[ks] = pr * 128 + (((2 * ks + hh) ^ ((pr >> 1) & 7)) << 4);
#pragma unroll
  for (int q = 0; q < 4; ++q) vo[q] = r * 128 + (((2 * q + hh) ^ ((r >> 1) & 7)) << 4);
  bf16x8 qf[4];
#pragma unroll
  for (int ks = 0; ks < 4; ++ks) qf[ks] = *(const bf16x8*)(p->P + (size_t)qrow * INC + 512 + h * 128 + comp * 64 + 16 * ks + 8 * hh);
  f32x16 o[4];
#pragma unroll
  for (int d = 0; d < 4; ++d)
#pragma unroll
    for (int i = 0; i < 16; ++i) o[d][i] = 0.f;
  float m, lsum;
  const bf16_t* vt = p->Vtd + (size_t)((b * 4 + h) * 128) * NKEY;
  const bf16_t* Pk = p->P + 1024 + h * 128;
  const int row8 = 8 * w + (lane >> 3), swz = ((lane & 7) ^ ((row8 >> 1) & 7)) << 4;
  const unsigned kq = (unsigned)(row8 * (INC * 2) + swz), vq = (unsigned)(row8 * (NKEY * 2) + swz);
#define DISSUE(kt, stg) do { const int krow_ = (kt) < 4 ? TL + b * CTXL + (kt) * 64 : b * SEQ + ((kt) - 4) * 64; \
    const char* kb_ = (const char*)(Pk + (size_t)krow_ * INC) + kq; const char* vb_ = (const char*)(vt + (kt) * 64) + vq; \
    lds_u8* sb_ = L + (stg) * STG + w * 1024; \
    GLDS16(kb_, sb_); GLDS16(kb_ + 128, sb_ + 8192); GLDS16(vb_, sb_ + 16384); GLDS16(vb_ + (size_t)64 * NKEY * 2, sb_ + 24576); } while (0)
#define VLOAD(dst, sbv, q) do { _Pragma("unroll") for (int d_ = 0; d_ < 4; ++d_) dst[d_] = *(const lds_bf16x8*)((sbv) + vo[q] + d_ * 4096); } while (0)
  asm volatile("s_waitcnt vmcnt(0)" ::: "memory");
  __syncthreads();
  DISSUE(0, 0);
  DISSUE(1, 1);
  asm volatile("s_waitcnt vmcnt(4)" ::: "memory");
  __builtin_amdgcn_s_barrier();
  bf16x8 P[4];
  {
    f32x16 st[2];
    qk_tile(qf, L + comp * 8192, ko, st);
    m = tile_max(st);
    lsum = exp_pack(st, m, P);
  }
  int stg = 0;
  bool need = false; float alpha = 1.f;
  if (w >= 4) __builtin_amdgcn_s_setprio(1);
  bf16x8 vA[4], vB[4];
  VLOAD(vA, L + 16384, 0); VLOAD(vB, L + 16384, 1);
#define FENCE __builtin_amdgcn_sched_barrier(0)
#pragma unroll 1
  for (int kt = 0; kt < nt - 1; ++kt) {
    asm volatile("s_waitcnt vmcnt(0)" ::: "memory");
    __builtin_amdgcn_s_barrier();
    const int stg1 = stg == 2 ? 0 : stg + 1;
    if (kt + 2 < nt) { const int s2_ = stg >= 1 ? stg - 1 : 2; DISSUE(kt + 2, s2_); }
    if (need) {
#pragma unroll
      for (int d = 0; d < 4; ++d) o[d] *= alpha;
    }
    const lds_u8* sbv = L + stg * STG + 16384;
    const lds_u8* sbk = L + stg1 * STG + comp * 8192;
    bf16x8 kf[2][4];
    f32x16 st[2];
#pragma unroll
    for (int t = 0; t < 2; ++t)
#pragma unroll
      for (int ks = 0; ks < 4; ++ks) kf[t][ks] = *(const lds_bf16x8*)(sbk + ko[ks] + t * 4096);
    FENCE;
    pv_grp(o, vA, P[0]); pv_grp(o, vB, P[1]);
    VLOAD(vA, sbv, 2); VLOAD(vB, sbv, 3);
    FENCE;
#pragma unroll
    for (int i = 0; i < 16; ++i) { st[0][i] = 0.f; st[1][i] = 0.f; }
#pragma unroll
    for (int ks = 0; ks < 4; ++ks) st[0] = MFMA32(kf[0][ks], qf[ks], st[0]);
#pragma unroll
    for (int ks = 0; ks < 4; ++ks) st[1] = MFMA32(kf[1][ks], qf[ks], st[1]);
    FENCE;
    pv_grp(o, vA, P[2]);
    const float mx = tile_max(st);
    need = !__all(mx <= m + 8.0f);
    const float mn = need ? fmaxf(m, mx) : m;
    alpha = __builtin_amdgcn_exp2f(m - mn);
    FENCE;
    float ps = exp_pack1<0>(st, mn, P[0]);
    ps += exp_pack1<1>(st, mn, P[1]);
    ps += exp_pack1<2>(st, mn, P[2]);
    pv_grp(o, vB, P[3]);
    ps += exp_pack1<3>(st, mn, P[3]);
#pragma unroll
    for (int q = 0; q < 4; ++q) { __builtin_amdgcn_sched_group_barrier(0x402, 18, 0); __builtin_amdgcn_sched_group_barrier(0x008, 1, 0); }
    lsum = lsum * alpha + ps; m = mn;
    FENCE;
    { const lds_u8* sbn = L + stg1 * STG + 16384; VLOAD(vA, sbn, 0); VLOAD(vB, sbn, 1); }
    stg = stg1;
  }
  __builtin_amdgcn_s_setprio(0);
  if (need) {
#pragma unroll
    for (int d = 0; d < 4; ++d) o[d] *= alpha;
  }
  {
    const lds_u8* sbv = L + stg * STG + 16384;
    pv_grp(o, vA, P[0]); pv_grp(o, vB, P[1]);
    VLOAD(vA, sbv, 2); VLOAD(vB, sbv, 3);
    pv_grp(o, vA, P[2]);
    pv_grp(o, vB, P[3]);
  }
#undef FENCE
#undef DISSUE
#undef VLOAD
  __syncthreads();
  const float ltot = lsum + __shfl_xor(lsum, 32);
  const float inv = 1.0f / ltot;
  float* Ob = (float*)ldsc + grp * 4096 + lane;
  if (comp == 1) {
#pragma unroll
    for (int d = 0; d < 4; ++d)
#pragma unroll
      for (int i = 0; i < 16; ++i) Ob[(d * 16 + i) * 64] = o[d][i] * inv;
  }
  __syncthreads();
  if (comp == 0) {
    float ss = 0.f;
#pragma unroll
    for (int d = 0; d < 4; ++d)
#pragma unroll
      for (int i = 0; i < 16; ++i) { const float v = o[d][i] * inv - lamv * Ob[(d * 16 + i) * 64]; o[d][i] = v; ss += v * v; }
    ss += __shfl_xor(ss, 32);
    const float sc = (1.0f - lam_init) / sqrtf(ss * (1.0f / 128.0f) + 1e-6f);
    const float* sg = p->subln_g + l * 128;
    bf16_t* mrow = p->MIX + (size_t)qrow * D + 256 + h * 128;
#pragma unroll
    for (int d = 0; d < 4; ++d)
#pragma unroll
      for (int i4 = 0; i4 < 4; ++i4) {
        const int dv = 32 * d + 8 * i4 + 4 * hh;
        const f32x4 gv = *(const f32x4*)(sg + dv);
        u32x2 ov; ov.x = pk2(o[d][4 * i4 + 0] * sc * gv[0], o[d][4 * i4 + 1] * sc * gv[1]); ov.y = pk2(o[d][4 * i4 + 2] * sc * gv[2], o[d][4 * i4 + 3] * sc * gv[3]);
        *(u32x2*)(mrow + dv) = ov;
      }
  }
}

DI void na_unit(KP p, int l, int b, int h, int rb, int isctx, char* ldsc) {
  const int tid = tid_(), lane = tid & 63, w = __builtin_amdgcn_readfirstlane(tid >> 6), r = lane & 31, hh = lane >> 5;
  const int pr = (r & ~12) | ((r & 4) << 1) | ((r & 8) >> 1);
  const int rq0 = rb * 4, rq = rq0 + (w >> 1), cq = (w & 1) * 32 + r;
  const int qrow = isctx ? TL + b * CTXL + w * 32 + r : b * SEQ + rq * 64 + cq;
  const int r0w = min(max(rq - 4, 0), 120);
  const int c0 = min(max(cq - 8, 0), 48);
  const int rlo = min(max(rq0 - 4, 0), 120), rhi = min(max(rq0 + 3 - 4, 0), 120) + 7;
  const int nt = isctx ? 4 : 4 + (rhi - rlo + 1);
  lds_u8* L = (lds_u8*)ldsc;
  float* rpbs = (float*)(ldsc + LDS_CONST + 64);
  constexpr int STG = 16384;
  int ko[4], vo[4];
#pragma unroll
  for (int ks = 0; ks < 4; ++ks) ko[ks] = pr * 128 + (((2 * ks + hh) ^ ((pr >> 1) & 7)) << 4);
#pragma unroll
  for (int q = 0; q < 4; ++q) vo[q] = r * 128 + (((2 * q + hh) ^ ((r >> 1) & 7)) << 4);
  asm volatile("s_waitcnt vmcnt(0)" ::: "memory");
  __syncthreads();
  if (!isctx) for (int e = tid; e < 465; e += NT) rpbs[e] = p->rpb[(size_t)(l * 4 + h) * 465 + e] * LOG2E;
  bf16x8 qf[4];
#pragma unroll
  for (int ks = 0; ks < 4; ++ks) qf[ks] = *(const bf16x8*)(p->P + (size_t)qrow * INC + 2048 + h * 64 + 16 * ks + 8 * hh);
  f32x16 o[2];
#pragma unroll
  for (int d = 0; d < 2; ++d)
#pragma unroll
    for (int i = 0; i < 16; ++i) o[d][i] = 0.f;
  float m = -3.0e38f, lsum = 0.f;
  const bf16_t* vt = p->Vtn + (size_t)((b * 4 + h) * 64) * NKEY;
  const bf16_t* Pk = p->P + 2304 + h * 64;
  const int row8 = 8 * w + (lane >> 3), swz = ((lane & 7) ^ ((row8 >> 1) & 7)) << 4;
  const unsigned kq = (unsigned)(row8 * (INC * 2) + swz), vq = (unsigned)(row8 * (NKEY * 2) + swz);
#define NISSUE(kt, stg) do { const int kr_ = (kt) < 4 ? TL + b * CTXL + (kt) * 64 : b * SEQ + (rlo + (kt) - 4) * 64; const int kp_ = (kt) < 4 ? (kt) * 64 : CTXL + (rlo + (kt) - 4) * 64; \
    lds_u8* sb_ = L + (stg) * STG + w * 1024; \
    GLDS16((const char*)(Pk + (size_t)kr_ * INC) + kq, sb_); GLDS16((const char*)(vt + kp_) + vq, sb_ + 8192); } while (0)
  asm volatile("s_waitcnt vmcnt(0)" ::: "memory");
  NISSUE(0, 0);
  NISSUE(1, 1);
  int stg = 0;
#pragma unroll 1
  for (int kt = 0; kt < nt; ++kt) {
    if (kt + 1 < nt) asm volatile("s_waitcnt vmcnt(2)" ::: "memory"); else asm volatile("s_waitcnt vmcnt(0)" ::: "memory");
    asm volatile("s_waitcnt lgkmcnt(0)" ::: "memory");
    __builtin_amdgcn_s_barrier();
    if (kt + 2 < nt) { const int s2_ = stg >= 1 ? stg - 1 : 2; NISSUE(kt + 2, s2_); }
    const lds_u8* sb = L + stg * STG;
    if (kt < 4) attn_tile<64, false>(qf, sb, sb + 8192, ko, vo, o, m, lsum, hh, nullptr, 0, 0, 0);
    else {
      const int rk = rlo + kt - 4;
      if (rk >= r0w && rk < r0w + 8) attn_tile<64, true>(qf, sb, sb + 8192, ko, vo, o, m, lsum, hh, rpbs, rk - rq + 7, cq, c0);
    }
    stg = stg == 2 ? 0 : stg + 1;
  }
#undef NISSUE
  const float ltot = lsum + __shfl_xor(lsum, 32);
  const float inv = 1.0f / ltot;
  bf16_t* mrow = p->MIX + (size_t)qrow * D + 768 + h * 64;
#pragma unroll
  for (int d = 0; d < 2; ++d)
#pragma unroll
    for (int i4 = 0; i4 < 4; ++i4) {
      const int dv = 32 * d + 8 * i4 + 4 * hh;
      u32x2 ov; ov.x = pk2(o[d][4 * i4 + 0] * inv, o[d][4 * i4 + 1] * inv); ov.y = pk2(o[d][4 * i4 + 2] * inv, o[d][4 * i4 + 3] * inv);
      *(u32x2*)(mrow + dv) = ov;
    }
}

DI void phase_attn(KP p, int l, char* ldsc) {
  const bool last = l == DEPTH - 1;
  const float lam_init = 0.8f - 0.6f * expf(-0.3f * (float)l);
  float* cst = (float*)(ldsc + LDS_CONST);
  __syncthreads();
  if (tid_() < 64) {
    const float* dl = p->diff_lam + l * 256;
    const int i = tid_();
    const float s1 = wave_sum(dl[i] * dl[64 + i]), s2 = wave_sum(dl[128 + i] * dl[192 + i]);
    if (i == 0) cst[0] = expf(s1) - expf(s2) + lam_init;
  }
  __syncthreads();
  const float lamv = cst[0];
  const int nb = gdim_(), bid = bid_();
#pragma unroll 1
  for (int r = bid; r < 512; r += nb) diff_unit(p, l, r >> 8, (r >> 6) & 3, r & 63, 0, lamv, lam_init, ldsc);
#if PROBE_DUP == 6
#pragma unroll 1
  for (int r = bid; r < 512; r += nb) diff_unit(p, l, r >> 8, (r >> 6) & 3, r & 63, 0, lamv, lam_init, ldsc);
#endif
#pragma unroll 1
  for (int r = bid; r < 256; r += nb) na_unit(p, l, r >> 7, (r >> 5) & 3, r & 31, 0, ldsc);
#pragma unroll 1
  for (int r = bid; r < (last ? 64 : 66) * 4; r += nb) lru_group_unit<1>(p, l, r >> 2, r & 3, ldsc);
#if PROBE_DUP == 4
#pragma unroll 1
  for (int r = bid; r < (last ? 64 : 66) * 4; r += nb) lru_group_unit<1>(p, l, r >> 2, r & 3, ldsc);
#endif
#if PROBE_DUP == 5
#pragma unroll 1
  for (int r = bid; r < 256; r += nb) na_unit(p, l, r >> 7, (r >> 5) & 3, r & 31, 0, ldsc);
#endif
  if (!last) {
#pragma unroll 1
    for (int r = nb - 1 - bid; r < 16; r += nb) diff_unit(p, l, r >> 3, (r >> 1) & 3, r & 1, 1, lamv, lam_init, ldsc);
#pragma unroll 1
    for (int r = nb - 17 - bid; r >= 0 && r < 8; r += nb) na_unit(p, l, r >> 2, r & 3, 0, 1, ldsc);
  }
}

__global__ void __launch_bounds__(512) mega(Params pv) {
  extern __shared__ __attribute__((aligned(16))) char lds[];
  cg::grid_group grid = cg::this_grid();
  volatile LAS unsigned* xst = (volatile LAS unsigned*)((LAS char*)lds + 131072);
  if (threadIdx.x == 0) { xst[0] = 0u; xst[1] = 0u; xst[2] = 0u; xst[3] = 0u; }
  __syncthreads();
  (void)xcd_barrier_post(get_params()->bar, xst);
#define XBAR() do { XcdBarrier xb_; xb_.bar = get_params()->bar; xb_.x = xb_xcc_id(); xb_.st = (volatile LAS unsigned*)((LAS char*)lds + 131072); xcd_barrier(xb_); } while (0)
  phase_prologue(get_params(), lds);
  if (gridDim.x == 0x7fffffffu) grid.sync();
  XBAR();
#pragma unroll 1
  for (int l = 0; l < DEPTH; ++l) {
    const bool last = l == DEPTH - 1;
    const int Mr = last ? TL : T;
    { KP p = get_params(); phase_norm(p, p->norm1_g + l * D, p->mods + (size_t)l * 3 * 6144, 0, 1, T, l ? p->X : p->x, l ? p->X + (size_t)TL * D : p->ctx); }
    XBAR();
#if PROBE_DUP == 2
    { KP p = get_params(); GemmArgs g; g.A = p->H; g.Bt = p->Win_t + (size_t)l * INC * D; g.M = T; g.N = INC; g.K = D; g.ctx = 0; g.mode = 0; g.Ob = p->P; g.X = nullptr; g.gate = nullptr; g.rope = p->rope; g.Xlat = nullptr; g.Xctx = nullptr; gemm_phase(g, lds); }
    XBAR();
#endif
    { KP p = get_params(); GemmArgs g; g.A = p->H; g.Bt = p->Win_t + (size_t)l * INC * D; g.M = T; g.N = INC; g.K = D; g.ctx = 0; g.mode = 0; g.Ob = p->P; g.X = nullptr; g.gate = nullptr; g.rope = p->rope; g.Xlat = nullptr; g.Xctx = nullptr; gemm_phase(g, lds); }
    XBAR();
    phase_prep(get_params(), l, lds);
    XBAR();
    phase_attn(get_params(), l, lds);
    XBAR();
#if PROBE_DUP == 1
    phase_attn(get_params(), l, lds);
    XBAR();
#endif
#if PROBE_DUP == 2
    { KP p = get_params(); GemmArgs g; g.A = p->MIX; g.Bt = p->Wout_t + (size_t)l * D * D; g.M = Mr; g.N = D; g.K = D; g.ctx = 0; g.mode = 0; g.Ob = p->P; g.X = nullptr; g.gate = nullptr; g.rope = nullptr; g.Xlat = nullptr; g.Xctx = nullptr; gemm_phase(g, lds); }
    XBAR();
#endif
    { KP p = get_params(); GemmArgs g; g.A = p->MIX; g.Bt = p->Wout_t + (size_t)l * D * D; g.M = TL; g.ctx = !last; g.N = D; g.K = D; g.mode = 1; g.Ob = nullptr; g.X = p->X; g.gate = p->mods + (size_t)l * 3 * 6144 + 2 * 1024; g.rope = nullptr; g.Xlat = l ? p->X : p->x; g.Xctx = l ? p->X + (size_t)TL * D : p->ctx; gemm_phase(g, lds); }
    XBAR();
    { KP p = get_params(); phase_norm(p, p->norm2_g + l * D, p->mods + (size_t)l * 3 * 6144, 3, 4, Mr, p->X, p->X + (size_t)TL * D); }
    XBAR();
#if PROBE_DUP == 2
    { KP p = get_params(); GemmArgs g; g.A = p->H; g.Bt = p->Wgu_t + (size_t)l * 2 * FFH * D; g.M = Mr; g.N = 2 * FFH; g.K = D; g.ctx = 0; g.mode = 2; g.Ob = p->P; g.X = nullptr; g.gate = nullptr; g.rope = nullptr; g.Xlat = nullptr; g.Xctx = nullptr; gemm_phase(g, lds); }
    XBAR();
#endif
    { KP p = get_params(); GemmArgs g; g.A = p->H; g.Bt = p->Wgu_t + (size_t)l * 2 * FFH * D; g.M = Mr; g.N = 2 * FFH; g.K = D; g.ctx = 0; g.mode = 2; g.Ob = p->P; g.X = nullptr; g.gate = nullptr; g.rope = nullptr; g.Xlat = nullptr; g.Xctx = nullptr; gemm_phase(g, lds); }
    XBAR();
#if PROBE_DUP == 2
    { KP p = get_params(); GemmArgs g; g.A = p->P; g.Bt = p->Wdown_t + (size_t)l * D * FFH; g.M = Mr; g.N = D; g.K = FFH; g.ctx = 0; g.mode = 0; g.Ob = p->MIX; g.X = nullptr; g.gate = nullptr; g.rope = nullptr; g.Xlat = nullptr; g.Xctx = nullptr; gemm_phase(g, lds); }
    XBAR();
#endif
    { KP p = get_params(); GemmArgs g; g.A = p->P; g.Bt = p->Wdown_t + (size_t)l * D * FFH; g.M = TL; g.ctx = !last; g.N = D; g.K = FFH; g.mode = 1; g.Ob = nullptr; g.X = p->X; g.gate = p->mods + (size_t)l * 3 * 6144 + 5 * 1024; g.rope = nullptr; g.Xlat = p->X; g.Xctx = p->X + (size_t)TL * D; gemm_phase(g, lds); }
    XBAR();
  }
  phase_final(get_params());
}

extern "C" void kernel_launch(void* const* d_in, const int* in_sizes, int n_in, void* d_out, int out_size, void* d_ws, size_t ws_size, hipStream_t stream) {
  static int grid_blocks = 0;
  if (!grid_blocks) {
    int dev = 0, cus = 0, per_cu = 0;
    hipGetDevice(&dev);
    hipDeviceGetAttribute(&cus, hipDeviceAttributeMultiprocessorCount, dev);
    hipFuncSetAttribute((const void*)mega, hipFuncAttributeMaxDynamicSharedMemorySize, LDS_BYTES);
    hipOccupancyMaxActiveBlocksPerMultiprocessor(&per_cu, (const void*)mega, NT, LDS_BYTES);
    if (per_cu < 1) per_cu = 1;
    grid_blocks = cus * per_cu;
  }
  Params p{};
  const float* const* in = (const float* const*)d_in;
  p.x = in[0]; p.c = in[1]; p.ctx = in[2]; p.c_ctx = in[3]; p.w_mod = in[4]; p.b_mod = in[5]; p.norm1_g = in[6]; p.norm2_g = in[7]; p.w_in = in[8];
  p.conv_w = in[9]; p.conv_b = in[10]; p.lru_wa = in[11]; p.lru_ba = in[12]; p.lru_wx = in[13]; p.lru_bx = in[14]; p.lru_lam = in[15]; p.diff_lam = in[16];
  p.subln_g = in[17]; p.rpb = in[18]; p.w_out = in[19]; p.w_gu = in[20]; p.w_down = in[21]; p.final_g = in[22];
  p.out = (float*)d_out;
  char* ws = (char*)d_ws; size_t off = 0;
  auto take = [&](size_t bytes) { char* q = ws + off; off += (bytes + 255) & ~(size_t)255; return q; };
  p.Win_t = (bf16_t*)take((size_t)DEPTH * INC * D * 2);
  p.Wout_t = (bf16_t*)take((size_t)DEPTH * D * D * 2);
  p.Wgu_t = (bf16_t*)take((size_t)DEPTH * 2 * FFH * D * 2);
  p.Wdown_t = (bf16_t*)take((size_t)DEPTH * D * FFH * 2);
  p.Wl = (bf16_t*)take((size_t)64 * 4096 * 2);
  p.X = (float*)take((size_t)T * D * 4);
  p.H = (bf16_t*)take((size_t)T * D * 2);
  p.P = (bf16_t*)take((size_t)T * INC * 2);
  p.MIX = (bf16_t*)take((size_t)T * D * 2);
  p.Vtd = (bf16_t*)take((size_t)NBATCH * 4 * 128 * NKEY * 2);
  p.Vtn = (bf16_t*)take((size_t)NBATCH * 4 * 64 * NKEY * 2);
  p.mods = (float*)take((size_t)DEPTH * 3 * 6144 * 4);
  p.rope = (float*)take((size_t)128 * 16 * 2 * 4);
  p.aggS = (float*)take((size_t)66 * 8 * 2 * 256 * 2 * 4);
  p.aggG = (float*)take((size_t)66 * 2 * 256 * 2 * 4);
  p.bar = (unsigned*)take((size_t)XCD_BAR_WORDS * 4);
  if (off > ws_size) { fprintf(stderr, "kernel_launch: workspace too small: need %zu have %zu\n", off, ws_size); return; }
  if (hipMemsetAsync(p.bar, 0, (size_t)XCD_BAR_WORDS * 4, stream) != hipSuccess) { fprintf(stderr, "kernel_launch: memset of barrier words failed\n"); return; }
  void* args[] = {&p};
  hipError_t e = hipLaunchCooperativeKernel((void*)mega, dim3(grid_blocks), dim3(NT), args, LDS_BYTES, stream);
  if (e != hipSuccess) fprintf(stderr, "cooperative launch failed: %s (grid %d)\n", hipGetErrorString(e), grid_blocks);
}
```

```cpp
#include <hip/hip_runtime.h>
#include <hip/hip_cooperative_groups.h>
#include <cstdio>
#include <cstdint>
namespace cg = cooperative_groups;
#ifndef PROBE_DUP
#define PROBE_DUP 0
#endif

typedef unsigned short bf16_t;
typedef short bf16x8 __attribute__((ext_vector_type(8)));
typedef float f32x4 __attribute__((ext_vector_type(4)));
typedef float f32x16 __attribute__((ext_vector_type(16)));
typedef unsigned u32x4 __attribute__((ext_vector_type(4)));
typedef unsigned u32x2 __attribute__((ext_vector_type(2)));

#define DI __device__ __forceinline__
#define MFMA32(a, b, c) __builtin_amdgcn_mfma_f32_32x32x16_bf16((a), (b), (c), 0, 0, 0)
#define MFMA16(a, b, c) __builtin_amdgcn_mfma_f32_16x16x32_bf16((a), (b), (c), 0, 0, 0)

constexpr int D = 1024, SEQ = 8192, NBATCH = 2, DEPTH = 4, CTXL = 256;
constexpr int TL = NBATCH * SEQ, TC = NBATCH * CTXL, T = TL + TC;
constexpr int INC = 2816, FFH = 2816, NKEY = CTXL + SEQ;
constexpr int LDS_BYTES = 131072 + 16;
constexpr int LDS_CONST = 122880;
constexpr int NT = 512;

struct Params {
  const float *x, *c, *ctx, *c_ctx, *w_mod, *b_mod, *norm1_g, *norm2_g, *w_in, *conv_w, *conv_b, *lru_wa, *lru_ba, *lru_wx, *lru_bx,
      *lru_lam, *diff_lam, *subln_g, *rpb, *w_out, *w_gu, *w_down, *final_g;
  float* out;
  bf16_t *Win_t, *Wout_t, *Wgu_t, *Wdown_t, *Wl;
  float* X;
  bf16_t *H, *P, *MIX, *Vtd, *Vtn;
  float *mods, *rope, *aggS, *aggG;
  unsigned* bar;
};

typedef const __attribute__((address_space(4))) Params* KP;
DI KP get_params() { KP kp = (KP)__builtin_amdgcn_kernarg_segment_ptr(); asm volatile("" : "+s"(kp)); return kp; }

#define XB_TMO      128
#define XB_XCNT(j)  (256  + 64 * (j))
#define XB_XSUB(j)  (1280 + 64 * (j))
#define XB_XGEN(j)  (2304 + 64 * (j))
#define XB_TOP      3328
#define XB_TOPGEN   3392
#define XCD_BAR_WORDS 3456
#define XB_SPIN_CAP (1u << 22)
#define LAS __attribute__((address_space(3)))
DI unsigned xb_ld(unsigned* p)              { return __hip_atomic_load(p, __ATOMIC_RELAXED, __HIP_MEMORY_SCOPE_AGENT); }
DI unsigned xb_add(unsigned* p, unsigned v) { return __hip_atomic_fetch_add(p, v, __ATOMIC_RELAXED, __HIP_MEMORY_SCOPE_AGENT); }
DI unsigned xb_xcc_id() { return (unsigned)__builtin_amdgcn_s_getreg((3 << 11) | 20) & 0xFu; }
#define XB_SPIN(cond, bar) do { unsigned _sp = 0; while (cond) { __builtin_amdgcn_s_sleep(1); \
    if ((++_sp & 255u) == 0u) { if (xb_ld(&(bar)[XB_TMO])) break; if (_sp > XB_SPIN_CAP) { atomicAdd(&(bar)[XB_TMO], 1u); break; } } } } while (0)
struct XcdBarrier { unsigned* bar; unsigned x; volatile LAS unsigned* st; };
DI XcdBarrier xcd_barrier_post(unsigned* bar, volatile LAS unsigned* st) {
  XcdBarrier b; b.bar = bar; b.x = xb_xcc_id(); b.st = st;
  if (threadIdx.x == 0) (void)xb_add(&bar[XB_XCNT(b.x)], 1u);
  return b;
}
DI void xcd_barrier_complete(unsigned* bar, unsigned x, unsigned& nloc, unsigned& nx) {
  const unsigned G = gridDim.x * gridDim.y * gridDim.z;
  unsigned sum, cnt, mine, sp = 0u;
  for (;;) {
    sum = 0u; cnt = 0u; mine = 0u;
#pragma unroll
    for (unsigned j = 0; j < 16; ++j) { const unsigned c = xb_ld(&bar[XB_XCNT(j)]); sum += c; cnt += (c > 0u) ? 1u : 0u; mine = (j == x) ? c : mine; }
    if (sum == G) break;
    __builtin_amdgcn_s_sleep(1);
    if ((++sp & 255u) == 0u) { if (xb_ld(&bar[XB_TMO])) break; if (sp > XB_SPIN_CAP) { atomicAdd(&bar[XB_TMO], 1u); break; } }
  }
  nloc = mine > 0u ? mine : 1u; nx = cnt > 0u ? cnt : 1u;
}
DI void xcd_barrier(const XcdBarrier& b) {
  asm volatile("s_waitcnt vmcnt(0)" ::: "memory");
  __syncthreads();
  if (threadIdx.x == 0) {
    unsigned* bar = b.bar;
    __builtin_amdgcn_s_waitcnt(0);
    unsigned nloc = b.st[0], nx = b.st[1];
    if (nloc == 0u) { xcd_barrier_complete(bar, b.x, nloc, nx); b.st[0] = nloc; b.st[1] = nx; }
    const unsigned old = xb_add(&bar[XB_XSUB(b.x)], 1u);
    const unsigned gen = old / nloc;
    if (old + 1u == (gen + 1u) * nloc) {
      __builtin_amdgcn_fence(__ATOMIC_RELEASE, "agent");
      asm volatile("s_waitcnt vmcnt(0)" ::: "memory");
      const unsigned og = xb_add(&bar[XB_TOP], 1u);
      const unsigned tg = og / nx;
      if (og + 1u == (tg + 1u) * nx) xb_add(&bar[XB_TOPGEN], 1u);
      else XB_SPIN(xb_ld(&bar[XB_TOPGEN]) == tg, bar);
      __builtin_amdgcn_fence(__ATOMIC_ACQUIRE, "agent");
      xb_add(&bar[XB_XGEN(b.x)], 1u);
      asm volatile("s_waitcnt vmcnt(0)" ::: "memory");
    } else {
      XB_SPIN(xb_ld(&bar[XB_XGEN(b.x)]) == gen, bar);
      __builtin_amdgcn_fence(__ATOMIC_ACQUIRE, "agent");
      asm volatile("s_waitcnt vmcnt(0)" ::: "memory");
    }
  }
  __syncthreads();
}

DI int tid_() { int t = threadIdx.x; asm volatile("" : "+v"(t)); return t; }
DI int bid_() { int b = blockIdx.x; asm volatile("" : "+s"(b)); return b; }
DI int gdim_() { int g = gridDim.x; asm volatile("" : "+s"(g)); return g; }

DI unsigned f2bf(float x) { unsigned u = __float_as_uint(x); u += 0x7fffu + ((u >> 16) & 1u); return u >> 16; }
typedef __bf16 bf16v2_t __attribute__((ext_vector_type(2)));
typedef float f32x2 __attribute__((ext_vector_type(2)));
DI unsigned pk2(float lo, float hi) { f32x2 v = {lo, hi}; bf16v2_t b = __builtin_convertvector(v, bf16v2_t); return __builtin_bit_cast(unsigned, b); }
DI float bf2f(bf16_t v) { return __uint_as_float(((unsigned)v) << 16); }
DI float wave_sum(float v) {
#pragma unroll
  for (int o = 1; o < 64; o <<= 1) v += __shfl_xor(v, o);
  return v;
}
DI float xhalf_max(float v) { const auto r = __builtin_amdgcn_permlane32_swap(__float_as_uint(v), __float_as_uint(v), false, false); return fmaxf(__uint_as_float(r[0]), __uint_as_float(r[1])); }
DI float sigmoidf_(float x) { return __builtin_amdgcn_rcpf(1.f + __expf(-x)); }
DI float gelu_tanh(float x) { const float u = 0.7978845608028654f * (x + 0.044715f * x * x * x); return 0.5f * x * (1.f + tanhf(u)); }

DI void wt_unit(const float* W, int K, int N, bf16_t* WT, int kt, int ntile, bool gu, float* scr  ) {
  const int tid = tid_(), k0 = kt * 64, n0 = ntile * 128;
  __syncthreads();
  {
    const int n = tid & 127, kq = tid >> 7;
#pragma unroll 4
    for (int i = 0; i < 16; ++i) { const int k = kq * 16 + i; scr[k * 129 + n] = W[(size_t)(k0 + k) * N + n0 + n]; }
  }
  __syncthreads();
  {
    const int n = tid >> 2, kq = tid & 3;
    const float* s = scr + (kq * 16) * 129 + n;
    u32x4 o0, o1;
    o0.x = pk2(s[0 * 129], s[1 * 129]); o0.y = pk2(s[2 * 129], s[3 * 129]); o0.z = pk2(s[4 * 129], s[5 * 129]); o0.w = pk2(s[6 * 129], s[7 * 129]);
    o1.x = pk2(s[8 * 129], s[9 * 129]); o1.y = pk2(s[10 * 129], s[11 * 129]); o1.z = pk2(s[12 * 129], s[13 * 129]); o1.w = pk2(s[14 * 129], s[15 * 129]);
    const int nsrc = n0 + n;
    int ndst = nsrc;
    if (gu) { const int sel = nsrc < FFH ? 0 : 1; const int j = nsrc - sel * FFH; ndst = (j >> 4) * 32 + sel * 16 + (j & 15); }
    bf16_t* d = WT + (size_t)ndst * K + k0 + kq * 16;
    *(u32x4*)d = o0; *(u32x4*)(d + 8) = o1;
  }
}

DI void mods_unit(KP p, int l, int cb, float* lds) {
  const int tid = tid_();
  float* cond = lds;
  float* red = lds + 3072;
  __syncthreads();
  for (int i = tid; i < 3072; i += NT) { const int v = i >> 10, k = i & 1023; const float c = v < 2 ? p->c[v * 1024 + k] : p->c_ctx[k]; cond[i] = c / (1.f + __expf(-c)); }
  __syncthreads();
  const int c4 = tid & 31, kg = tid >> 5;
  f32x4 a0 = {0.f, 0.f, 0.f, 0.f}, a1 = a0, a2 = a0;
  const float* w = p->w_mod + (size_t)l * 1024 * 6144 + cb * 128 + c4 * 4;
#pragma unroll 8
  for (int k = kg * 64; k < kg * 64 + 64; ++k) { const f32x4 wv = *(const f32x4*)(w + (size_t)k * 6144); a0 += wv * cond[k]; a1 += wv * cond[1024 + k]; a2 += wv * cond[2048 + k]; }
  *(f32x4*)(red + (kg * 3 + 0) * 128 + c4 * 4) = a0; *(f32x4*)(red + (kg * 3 + 1) * 128 + c4 * 4) = a1; *(f32x4*)(red + (kg * 3 + 2) * 128 + c4 * 4) = a2;
  __syncthreads();
  if (tid < 384) {
    const int v = tid >> 7, c2 = tid & 127;
    float s_ = 0.f;
#pragma unroll
    for (int q = 0; q < 16; ++q) s_ += red[(q * 3 + v) * 128 + c2];
    p->mods[(size_t)(l * 3 + v) * 6144 + cb * 128 + c2] = s_ + p->b_mod[l * 6144 + cb * 128 + c2];
  }
}

DI void phase_prologue(KP p, char* ldsc) {
  const int tid = tid_(), nb = gdim_(), bid = bid_();
  float* lds = (float*)ldsc;
  constexpr int U_MODS = DEPTH * 48, U_IN = 16 * 22, U_OUT = 16 * 8, U_GU = 16 * 44, U_DN = 44 * 8, U_WL = U_IN + U_OUT + U_GU + U_DN;
  constexpr int U_TOTAL = U_MODS + DEPTH * U_WL + 64 + 1;
  for (int u = bid; u < U_TOTAL; u += nb) {
    int r = u;
    if (r < U_MODS) { mods_unit(p, r / 48, r % 48, lds); continue; }
    r -= U_MODS;
    if (r < DEPTH * U_WL) {
      const int l = r / U_WL; r -= l * U_WL;
      if (r < U_IN) { wt_unit(p->w_in + (size_t)l * D * INC, D, INC, p->Win_t + (size_t)l * INC * D, r / 22, r % 22, false, lds); continue; }
      r -= U_IN;
      if (r < U_OUT) { wt_unit(p->w_out + (size_t)l * D * D, D, D, p->Wout_t + (size_t)l * D * D, r / 8, r % 8, false, lds); continue; }
      r -= U_OUT;
      if (r < U_GU) { wt_unit(p->w_gu + (size_t)l * D * 2 * FFH, D, 2 * FFH, p->Wgu_t + (size_t)l * 2 * FFH * D, r / 44, r % 44, true, lds); continue; }
      r -= U_GU;
      wt_unit(p->w_down + (size_t)l * FFH * D, FFH, D, p->Wdown_t + (size_t)l * D * FFH, r / 8, r % 8, false, lds);
      continue;
    }
    r -= DEPTH * U_WL;
    if (r < 64) {
      const int l = r >> 4, n = (r >> 2) & 3, dir = (r >> 1) & 1, kind = r & 1;
      const float* src = (kind ? p->lru_wx : p->lru_wa) + (size_t)((l * 2 + dir) * 4 + n) * 4096;
      bf16_t* dst = p->Wl + (size_t)r * 4096;
      for (int e = tid; e < 4096; e += NT) { const int j = e >> 6, i = e & 63; dst[j * 64 + i] = (bf16_t)f2bf(src[i * 64 + j]); }
      continue;
    }
    for (int e = tid; e < 128 * 16; e += NT) {
      const int pos = e >> 4, i = e & 15;
      const float inv = 1.0f / powf(10000.0f, (float)(2 * i) / 32.0f);
      const float ang = (float)pos * inv;
      p->rope[e * 2] = cosf(ang); p->rope[e * 2 + 1] = sinf(ang);
    }
  }
}

DI void phase_norm(KP p, const float* g, const float* mods_l, int shift_idx, int scale_idx, int nrows, const float* xlat, const float* xctx) {
  const int lane = tid_() & 63, gw = bid_() * 8 + (tid_() >> 6), ngw = gdim_() * 8;
  constexpr int R = 4;
#pragma unroll 1
  for (int row0 = gw; row0 < nrows; row0 += R * ngw) {
    f32x4 v[R][4]; float ss[R];
#pragma unroll
    for (int r = 0; r < R; ++r) {
      const int row = min(row0 + r * ngw, nrows - 1);
      const float* xr = row < TL ? xlat + (size_t)row * D : xctx + (size_t)(row - TL) * D;
#pragma unroll
      for (int j = 0; j < 4; ++j) v[r][j] = *(const f32x4*)(xr + j * 256 + lane * 4);
    }
    const int vsu = row0 < SEQ ? 0 : (row0 < TL ? 1 : 2);
    f32x4 wv[4], sv[4];
#pragma unroll
    for (int j = 0; j < 4; ++j) {
      const int c = j * 256 + lane * 4;
      wv[j] = *(const f32x4*)(g + c) * (*(const f32x4*)(mods_l + vsu * 6144 + scale_idx * 1024 + c) + 1.0f);
      sv[j] = *(const f32x4*)(mods_l + vsu * 6144 + shift_idx * 1024 + c);
    }
#pragma unroll
    for (int r = 0; r < R; ++r) {
      float s_ = 0.f;
#pragma unroll
      for (int j = 0; j < 4; ++j) s_ += (v[r][j].x * v[r][j].x + v[r][j].y * v[r][j].y) + (v[r][j].z * v[r][j].z + v[r][j].w * v[r][j].w);
      ss[r] = wave_sum(s_);
    }
#pragma unroll
    for (int r = 0; r < R; ++r) {
      const int row = row0 + r * ngw;
      if (row < nrows) {
        const float rstd = 1.0f / sqrtf(ss[r] * (1.0f / D) + 1e-6f);
        const int vs = row < SEQ ? 0 : (row < TL ? 1 : 2);
        bf16_t* hr = p->H + (size_t)row * D;
        if (vs == vsu) {
#pragma unroll
          for (int j = 0; j < 4; ++j) {
            const f32x4 h = v[r][j] * rstd * wv[j] + sv[j];
            u32x2 o; o.x = pk2(h.x, h.y); o.y = pk2(h.z, h.w);
            *(u32x2*)(hr + j * 256 + lane * 4) = o;
          }
        } else {
          const float* sh = mods_l + vs * 6144 + shift_idx * 1024;
          const float* sc = mods_l + vs * 6144 + scale_idx * 1024;
#pragma unroll
          for (int j = 0; j < 4; ++j) {
            const int c = j * 256 + lane * 4;
            const f32x4 gv = *(const f32x4*)(g + c), shv = *(const f32x4*)(sh + c), scv = *(const f32x4*)(sc + c);
            const f32x4 h = v[r][j] * rstd * (gv * (scv + 1.0f)) + shv;
            u32x2 o; o.x = pk2(h.x, h.y); o.y = pk2(h.z, h.w);
            *(u32x2*)(hr + c) = o;
          }
        }
      }
    }
  }
}

DI void phase_final(KP p) {
  const int lane = tid_() & 63, gw = bid_() * 8 + (tid_() >> 6), ngw = gdim_() * 8;
  constexpr int R = 4;
#pragma unroll 1
  for (int row0 = gw; row0 < TL; row0 += R * ngw) {
    f32x4 v[R][4]; float ss[R];
#pragma unroll
    for (int r = 0; r < R; ++r) {
      const int row = min(row0 + r * ngw, TL - 1);
      const float* xr = p->X + (size_t)row * D;
#pragma unroll
      for (int j = 0; j < 4; ++j) v[r][j] = *(const f32x4*)(xr + j * 256 + lane * 4);
    }
#pragma unroll
    for (int r = 0; r < R; ++r) {
      float s_ = 0.f;
#pragma unroll
      for (int j = 0; j < 4; ++j) s_ += (v[r][j].x * v[r][j].x + v[r][j].y * v[r][j].y) + (v[r][j].z * v[r][j].z + v[r][j].w * v[r][j].w);
      ss[r] = wave_sum(s_);
    }
#pragma unroll
    for (int r = 0; r < R; ++r) {
      const int row = row0 + r * ngw;
      if (row < TL) {
        const float rstd = 1.0f / sqrtf(ss[r] * (1.0f / D) + 1e-6f);
        float* orow = p->out + (size_t)row * D;
#pragma unroll
        for (int j = 0; j < 4; ++j) { const int c = j * 256 + lane * 4; const f32x4 gv = *(const f32x4*)(p->final_g + c); *(f32x4*)(orow + c) = v[r][j] * rstd * gv; }
      }
    }
  }
}

constexpr int BM = 256, BK = 64, HALF = 128, HT = HALF * BK;
DI int lds_byte(int r, int c) { const int st = (r >> 4) * 2 + (c >> 5), rr = r & 15, cc = c & 31, ob = rr * 64 + cc * 2; return st * 1024 + (ob ^ (((ob >> 9) & 1) << 5)); }
DI void stage_rc(int b, int& R, int& C) { const int st = b / 1024, sb = b % 1024, swz = sb ^ (((sb >> 9) & 1) << 5); R = (st >> 1) * 16 + swz / 64; C = (st & 1) * 32 + (swz % 64) / 2; }

struct GemmArgs { const bf16_t* A; const bf16_t* Bt; int M, N, K, mode; bf16_t* Ob; float* X; const float* gate; const float* rope; int ctx; const float* Xlat; const float* Xctx; };

DI void gemm_phase(const GemmArgs& g, char* shm_c) {
  typedef __attribute__((address_space(3))) unsigned char lds_u8;
  lds_u8* lds = (lds_u8*)shm_c;
  const int K = g.K;
  const int tid = tid_(), wid = __builtin_amdgcn_readfirstlane(tid >> 6), lane = tid & 63, wr = wid >> 2, wc = wid & 3, fr = lane & 15, fq = lane >> 4;
  unsigned voff[2];
#pragma unroll
  for (int i = 0; i < 2; ++i) { int R, C; stage_rc(tid * 16 + i * 8192, R, C); voff[i] = (unsigned)(R * K + C) * 2u; }
  const size_t kstep = (size_t)(BK * 2), hstep = (size_t)HALF * K * 2, tstep = 2 * hstep;
  const unsigned ldsw = (unsigned)wid * 1024u;
  const int aoff = lds_byte(wr * 64 + fr, fq * 8), boff = lds_byte(wc * 32 + fr, fq * 8);
#define SA(b, h) (((b) * 2 + (h)) * (HT * 2))
#define SB(b, h) ((4 + (b) * 2 + (h)) * (HT * 2))
#define STAGE(bufoff, gbase) do { _Pragma("unroll") for (int _i = 0; _i < 2; ++_i) \
    __builtin_amdgcn_global_load_lds((const unsigned*)((const char*)(gbase) + voff[_i]), (__attribute__((address_space(3))) unsigned*)(lds + (bufoff) + ldsw + _i * 8192), 16, 0, 0); } while (0)
#define LDA(dst, b, h) do { _Pragma("unroll") for (int m = 0; m < 4; ++m) _Pragma("unroll") for (int k = 0; k < 2; ++k) dst[m][k] = *(const __attribute__((address_space(3))) bf16x8*)(lds + SA(b, h) + aoff + m * 2048 + k * 1024); } while (0)
#define LDB(dst, b, h) do { _Pragma("unroll") for (int n = 0; n < 2; ++n) _Pragma("unroll") for (int k = 0; k < 2; ++k) dst[n][k] = *(const __attribute__((address_space(3))) bf16x8*)(lds + SB(b, h) + boff + n * 2048 + k * 1024); } while (0)
#define MMA(ai, bj, At_, Bt_) do { __builtin_amdgcn_s_setprio(1); \
    _Pragma("unroll") for (int m = 0; m < 4; ++m) _Pragma("unroll") for (int n = 0; n < 2; ++n) _Pragma("unroll") for (int k = 0; k < 2; ++k) \
      acc[ai][bj][m][n] = MFMA16(Bt_[n][k], At_[m][k], acc[ai][bj][m][n]); \
    __builtin_amdgcn_s_setprio(0); } while (0)
#define WAIT_V(n) asm volatile("s_waitcnt vmcnt(" #n ")" ::: "memory")
#define WAIT_L(n) asm volatile("s_waitcnt lgkmcnt(" #n ")" ::: "memory")
#define BAR __builtin_amdgcn_s_barrier()
#define SCHED __builtin_amdgcn_sched_barrier(0)
  const int nM = g.M / BM, nN = g.N / BM, ntiles = nM * nN;
  const int nt = K / BK;
#define TILE_PMPN(tile_, pm_, pn_) do { int wgid = (tile_); const int q = ntiles / 8, rr = ntiles % 8, xcd = wgid % 8, off = wgid / 8; \
    wgid = (xcd < rr ? xcd * (q + 1) : rr * (q + 1) + (xcd - rr) * q) + off; \
    const int nig = 8 * nN, gid = wgid / nig, fm = gid * 8, gsz = (nM - fm) < 8 ? (nM - fm) : 8; \
    pm_ = fm + ((wgid % nig) % gsz); pn_ = (wgid % nig) / gsz; } while (0)
#define PRO_ISSUE(cA_, cB_) do { STAGE(SB(0, 0), cB_); STAGE(SA(0, 0), cA_); STAGE(SB(0, 1), (cB_) + hstep); STAGE(SA(0, 1), (cA_) + hstep); \
    STAGE(SB(1, 0), (cB_) + kstep); STAGE(SA(1, 0), (cA_) + kstep); STAGE(SB(1, 1), (cB_) + hstep + kstep); } while (0)
  const int gstep = gdim_();
  int tile = bid_();
  int pm = 0, pn = 0;
  const char* cA = nullptr; const char* cB = nullptr;
  const bool has_work = tile < ntiles;
  f32x4 acc[2][2][4][2];
  bf16x8 At[4][2], B0[2][2], B1[2][2];
  if (has_work) {
    TILE_PMPN(tile, pm, pn); cA = (const char*)g.A + (size_t)pm * tstep; cB = (const char*)g.Bt + (size_t)pn * tstep;
#pragma unroll
    for (int a = 0; a < 2; ++a)
#pragma unroll
      for (int b = 0; b < 2; ++b)
#pragma unroll
        for (int m = 0; m < 4; ++m)
#pragma unroll
          for (int n = 0; n < 2; ++n) acc[a][b][m][n] = (f32x4){0.f, 0.f, 0.f, 0.f};
    STAGE(SB(0, 0), cB); STAGE(SB(0, 1), cB + hstep); STAGE(SA(0, 0), cA); STAGE(SA(0, 1), cA + hstep);
    if (wr == 1) BAR;
    WAIT_V(2); BAR;
    STAGE(SB(1, 0), cB + kstep); STAGE(SA(1, 0), cA + kstep); STAGE(SB(1, 1), cB + hstep + kstep);
    WAIT_V(6); BAR;
  }
#pragma unroll 1
  while (has_work) {
    const int brow = pm * BM, bcol = pn * BM;
    const int ntile = tile + gstep;
    const bool has_next = ntile < ntiles;
    int npm = pm, npn = pn;
    if (has_next) TILE_PMPN(ntile, npm, npn);
    const char* nA = (const char*)g.A + (size_t)npm * tstep; const char* nB = (const char*)g.Bt + (size_t)npn * tstep;
#pragma unroll 1
    for (int t = 0; t < nt; t += 2) {
      const bool last = t == nt - 2;
      const char* a1 = cA + (size_t)(t + 1) * kstep;
      const char* a2 = last ? nA : cA + (size_t)(t + 2) * kstep; const char* b2 = last ? nB : cB + (size_t)(t + 2) * kstep;
      const char* a3 = a2 + kstep; const char* b3 = b2 + kstep;
      LDB(B0, 0, 0); LDB(B1, 0, 1); SCHED; LDA(At, 0, 0); STAGE(SA(1, 1), a1 + hstep);
      WAIT_V(8); WAIT_L(0); BAR; MMA(0, 0, At, B0); MMA(0, 1, At, B1); BAR; SCHED;
      LDA(At, 0, 1); STAGE(SB(0, 0), b2); STAGE(SB(0, 1), b2 + hstep); STAGE(SA(0, 0), a2);
      WAIT_V(8); WAIT_L(0); BAR; MMA(1, 0, At, B0); MMA(1, 1, At, B1); BAR; SCHED;
      LDB(B0, 1, 0); LDB(B1, 1, 1); SCHED; LDA(At, 1, 0); STAGE(SA(0, 1), a2 + hstep);
      WAIT_V(8); WAIT_L(0); BAR; MMA(0, 0, At, B0); MMA(0, 1, At, B1); BAR; SCHED;
      LDA(At, 1, 1); STAGE(SB(1, 0), b3); STAGE(SB(1, 1), b3 + hstep); STAGE(SA(1, 0), a3);
      WAIT_V(8); WAIT_L(0); BAR; MMA(1, 0, At, B0); MMA(1, 1, At, B1); BAR; SCHED;
    }
    if (wr == 0) BAR;
    if (g.mode == 0) {
#pragma unroll
      for (int ai = 0; ai < 2; ++ai)
#pragma unroll
        for (int m = 0; m < 4; ++m) {
          const int row = brow + ai * HALF + wr * 64 + m * 16 + fr;
          bf16_t* rp0 = g.Ob + (size_t)row * g.N + bcol + wc * 32;
#pragma unroll
          for (int bj = 0; bj < 2; ++bj) {
            f32x4 v0 = acc[ai][bj][m][0], v1 = acc[ai][bj][m][1];
            const int gb = bcol + bj * HALF + wc * 32;
            if (g.rope != nullptr && gb >= 512 && gb < 1536 && brow < TL) {
              const int sq = row & (SEQ - 1), pos = (gb & 32) ? (sq & 63) : (sq >> 6);
              const float* rt = g.rope + (pos * 16 + 4 * fq) * 2;
              const f32x4 t0 = *(const f32x4*)rt, t1 = *(const f32x4*)(rt + 4);
              const f32x4 cs = {t0[0], t0[2], t1[0], t1[2]}, sn = {t0[1], t0[3], t1[1], t1[3]};
              const f32x4 r0 = v0 * cs - v1 * sn, r1 = v1 * cs + v0 * sn;
              v0 = r0; v1 = r1;
            }
            u32x2 a, b2; a.x = pk2(v0[0], v0[1]); a.y = pk2(v0[2], v0[3]); b2.x = pk2(v1[0], v1[1]); b2.y = pk2(v1[2], v1[3]);
            const auto sx = __builtin_amdgcn_permlane16_swap(a.x, b2.x, false, false);
            const auto sy = __builtin_amdgcn_permlane16_swap(a.y, b2.y, false, false);
            u32x4 w4; w4.x = sx[0]; w4.y = sy[0]; w4.z = sx[1]; w4.w = sy[1];
            *(u32x4*)(rp0 + bj * HALF + ((fq & 1) ? 16 + 4 * (fq - 1) : 4 * fq)) = w4;
          }
        }
    } else if (g.mode == 1) {
      const float* gp = g.gate + (brow < SEQ ? 0 : 1) * 6144 + bcol + wc * 32 + 4 * fq;
      f32x4 gvv[2][2];
#pragma unroll
      for (int bj = 0; bj < 2; ++bj)
#pragma unroll
        for (int n = 0; n < 2; ++n) gvv[bj][n] = *(const f32x4*)(gp + bj * HALF + n * 16);
#pragma unroll
      for (int ai = 0; ai < 2; ++ai)
#pragma unroll
        for (int m = 0; m < 4; ++m) {
          const int row = brow + ai * HALF + wr * 64 + m * 16 + fr;
          float* rp = g.X + (size_t)row * g.N + bcol + wc * 32 + 4 * fq;
          const float* rin = g.Xlat + (size_t)row * g.N + bcol + wc * 32 + 4 * fq;
#pragma unroll
          for (int bj = 0; bj < 2; ++bj)
#pragma unroll
            for (int n = 0; n < 2; ++n) {
              f32x4 xv = *(const f32x4*)(rin + bj * HALF + n * 16);
              xv += gvv[bj][n] * acc[ai][bj][m][n];
              *(f32x4*)(rp + bj * HALF + n * 16) = xv;
            }
        }
    } else {
      const int ldo = g.N >> 1;
#pragma unroll
      for (int ai = 0; ai < 2; ++ai)
#pragma unroll
        for (int m = 0; m < 4; ++m) {
          const int row = brow + ai * HALF + wr * 64 + m * 16 + fr;
          bf16_t* rp0 = g.Ob + (size_t)row * ldo + ((bcol + wc * 32) >> 1);
          u32x2 ob[2];
#pragma unroll
          for (int bj = 0; bj < 2; ++bj) {
            const f32x4 gg = acc[ai][bj][m][0], uu = acc[ai][bj][m][1];
            f32x4 r;
#pragma unroll
            for (int j = 0; j < 4; ++j) r[j] = gg[j] * sigmoidf_(gg[j]) * uu[j];
            ob[bj].x = pk2(r[0], r[1]); ob[bj].y = pk2(r[2], r[3]);
          }
          const auto sx = __builtin_amdgcn_permlane16_swap(ob[0].x, ob[1].x, false, false);
          const auto sy = __builtin_amdgcn_permlane16_swap(ob[0].y, ob[1].y, false, false);
          u32x4 w4; w4.x = sx[0]; w4.y = sy[0]; w4.z = sx[1]; w4.w = sy[1];
          *(u32x4*)(rp0 + ((fq & 1) ? HALF / 2 + 4 * (fq - 1) : 4 * fq)) = w4;
        }
    }
    if (!has_next) break;
#pragma unroll
    for (int a = 0; a < 2; ++a)
#pragma unroll
      for (int b = 0; b < 2; ++b)
#pragma unroll
        for (int m = 0; m < 4; ++m)
#pragma unroll
          for (int n = 0; n < 2; ++n) acc[a][b][m][n] = (f32x4){0.f, 0.f, 0.f, 0.f};
    tile = ntile; pm = npm; pn = npn; cA = nA; cB = nB;
    if (wr == 1) BAR;
  }
  if (has_work) {
    WAIT_V(0);
    BAR;
  }
  if (g.mode == 1 && g.ctx) {
    bf16_t* sAm = (bf16_t*)shm_c;
    bf16_t* sBm = sAm + 32 * 520;
#pragma unroll 1
    for (int piece = bid_(); piece < 256; piece += gstep) {
      const int rb = piece >> 4, cb = piece & 15, mt = wid >> 2, ntl = wid & 3;
      const bf16_t* Ag = g.A + (size_t)(TL + rb * 32) * K;
      const bf16_t* Bg = g.Bt + (size_t)(cb * 64) * K;
      const int prow = tid >> 6, pc = tid & 63;
      f32x4 c4 = {0.f, 0.f, 0.f, 0.f};
      u32x4 ra[4], rbv[8];
#define MLOAD(k0_) do { const int cw_ = (K - (k0_)) < 512 ? (K - (k0_)) : 512; if (pc * 8 < cw_) { \
        _Pragma("unroll") for (int u = 0; u < 4; ++u) ra[u] = *(const u32x4*)(Ag + (size_t)(prow + 8 * u) * K + (k0_) + pc * 8); \
        _Pragma("unroll") for (int u = 0; u < 8; ++u) rbv[u] = *(const u32x4*)(Bg + (size_t)(prow + 8 * u) * K + (k0_) + pc * 8); } } while (0)
      MLOAD(0);
#pragma unroll 1
      for (int k0 = 0; k0 < K; k0 += 512) {
        const int cw = (K - k0) < 512 ? (K - k0) : 512;
        __syncthreads();
        if (pc * 8 < cw) {
#pragma unroll
          for (int u = 0; u < 4; ++u) *(u32x4*)(sAm + (prow + 8 * u) * 520 + pc * 8) = ra[u];
#pragma unroll
          for (int u = 0; u < 8; ++u) *(u32x4*)(sBm + (prow + 8 * u) * 520 + pc * 8) = rbv[u];
        }
        __syncthreads();
        if (k0 + 512 < K) MLOAD(k0 + 512);
#pragma unroll 4
        for (int u = 0; u < cw / 32; ++u) {
          const bf16x8 av = *(const bf16x8*)(sAm + (mt * 16 + fr) * 520 + 32 * u + 8 * fq);
          const bf16x8 bv = *(const bf16x8*)(sBm + (ntl * 16 + fr) * 520 + 32 * u + 8 * fq);
          c4 = MFMA16(av, bv, c4);
        }
      }
#undef MLOAD
      const int col = cb * 64 + ntl * 16 + fr;
      const float gv = g.gate[2 * 6144 + col];
#pragma unroll
      for (int j = 0; j < 4; ++j) { const size_t ro = (size_t)(rb * 32 + mt * 16 + 4 * fq + j) * g.N + col; g.X[(size_t)TL * g.N + ro] = g.Xctx[ro] + gv * c4[j]; }
    }
    __syncthreads();
  }
#undef SA
#undef SB
#undef STAGE
#undef LDA
#undef LDB
#undef MMA
}

constexpr int LRU_WN = 0, LRU_CONST = 36864, LRU_CARRY = 38400, LRU_AGGW = 42496, LRU_PART = 50688, LRU_WAVE = 54784, LRU_WAVE_BYTES = 9216;

template <int MODE>
DI void lru_group_unit(KP p, int l, int g, int n, char* ldsc) {
  const int tid = tid_(), lane = tid & 63, w = __builtin_amdgcn_readfirstlane(tid >> 6), fr = lane & 15, fq = lane >> 4;
  bf16_t* Wn = (bf16_t*)(ldsc + LRU_WN);
  float* cst = (float*)(ldsc + LRU_CONST);
  float* carry = (float*)(ldsc + LRU_CARRY);
  float* aggw = (float*)(ldsc + LRU_AGGW);
  float* part = (float*)(ldsc + LRU_PART);
  bf16_t* xs = (bf16_t*)(ldsc + LRU_WAVE + w * LRU_WAVE_BYTES);
  bf16_t* xcb = xs + 36 * 64;
  const bool isctx = g >= 64;
  const int b = isctx ? g - 64 : g >> 5, gi = isctx ? 0 : g & 31;
  const int L = isctx ? CTXL : SEQ;
  const int row0 = g * 256 + w * 32;
  const int t0 = gi * 256 + w * 32;
  __syncthreads();
  {
    const bf16_t* Wg = p->Wl + (size_t)((l * 4 + n) * 4) * 4096;
#pragma unroll
    for (int u = 0; u < 4; ++u) { const int q = tid + NT * u, rowi = q >> 3, pc = q & 7;
      *(u32x4*)(Wn + rowi * 72 + pc * 8) = *(const u32x4*)(Wg + rowi * 64 + pc * 8); }
    if (tid < 128) { const int dir = tid >> 6, ch = tid & 63, gch = (l * 2 + dir) * 256 + n * 64 + ch;
      cst[tid * 3 + 0] = p->lru_ba[gch]; cst[tid * 3 + 1] = p->lru_bx[gch]; cst[tid * 3 + 2] = -8.0f * log1pf(expf(-p->lru_lam[gch])); }
    for (int q = lane; q < 35 * 8; q += 64) {
      const int tt = q >> 3, pc = q & 7, t = t0 + tt - 2;
      u32x4 v = {0u, 0u, 0u, 0u};
      if (t >= 0 && t < L) v = *(const u32x4*)(p->P + (size_t)(row0 + tt - 2) * INC + n * 64 + pc * 8);
      *(u32x4*)(xs + tt * 64 + pc * 8) = v;
    }
  }
  if (MODE == 1) {
    const int seg = tid >> 7, dir = (tid >> 6) & 1, ch = tid & 63, gch = n * 64 + ch;
    const int nch = isctx ? 0 : (dir == 0 ? 1 + gi : 32 - gi);
    float ca[8], cb[8];
#pragma unroll
    for (int e8 = 0; e8 < 8; ++e8) {
      const int e = seg * 8 + e8;
      const int ee = e < nch ? e : 0;
      const int gg = ee == 0 ? 64 + b : (dir == 0 ? b * 32 + (ee - 1) : b * 32 + 32 - ee);
      const float* q = p->aggG + ((size_t)(gg * 2 + dir) * 256 + gch) * 2;
      const float a_ = q[0], b_ = q[1];
      ca[e8] = e < nch ? a_ : 1.f; cb[e8] = e < nch ? b_ : 0.f;
    }
    float A = 1.f, B = 0.f;
#pragma unroll
    for (int e8 = 0; e8 < 8; ++e8) { B = ca[e8] * B + cb[e8]; A = A * ca[e8]; }
    part[((seg * 2 + dir) * 64 + ch) * 2 + 0] = A; part[((seg * 2 + dir) * 64 + ch) * 2 + 1] = B;
  }
  __syncthreads();
  {
    const int ch = lane;
    const float* cw = p->conv_w + l * 4 * 256 + n * 64 + ch;
    const float cb_ = p->conv_b[l * 256 + n * 64 + ch];
    const float w0 = cw[0], w1 = cw[256], w2 = cw[512], w3 = cw[768];
    float x0 = bf2f(xs[ch]), x1 = bf2f(xs[64 + ch]), x2 = bf2f(xs[128 + ch]);
#pragma unroll 8
    for (int t = 0; t < 32; ++t) {
      const float x3 = bf2f(xs[(t + 3) * 64 + ch]);
      const float y = cb_ + w0 * x0 + w1 * x1 + w2 * x2 + w3 * x3;
      xcb[t * 72 + ch] = (bf16_t)f2bf(y);
      x0 = x1; x1 = x2; x2 = x3;
    }
  }
  if (MODE == 1 && tid < 128) {
    const int dir = tid >> 6, ch = tid & 63, gch = n * 64 + ch;
    float h = 0.f;
#pragma unroll
    for (int sg = 0; sg < 4; ++sg) h = part[((sg * 2 + dir) * 64 + ch) * 2] * h + part[((sg * 2 + dir) * 64 + ch) * 2 + 1];
    float sa[8], sb[8];
#pragma unroll
    for (int w2 = 0; w2 < 8; ++w2) { const float* q = p->aggS + ((size_t)((g * 8 + w2) * 2 + dir) * 256 + gch) * 2; sa[w2] = q[0]; sb[w2] = q[1]; }
#pragma unroll
    for (int i = 0; i < 8; ++i) { const int w2 = dir == 0 ? i : 7 - i; carry[(w2 * 2 + dir) * 64 + ch] = h; h = sa[w2] * h + sb[w2]; }
  }
  __syncthreads();
  bf16x8 af[2][2];
#pragma unroll
  for (int m = 0; m < 2; ++m)
#pragma unroll
    for (int ks = 0; ks < 2; ++ks) af[m][ks] = *(const bf16x8*)(xcb + (16 * m + fr) * 72 + 32 * ks + 8 * fq);
  float hf[4][2][4];
#pragma unroll
  for (int dir = 0; dir < 2; ++dir)
#pragma unroll
    for (int cg = 0; cg < 4; ++cg) {
      const int ch = cg * 16 + fr;
      float gl[2][4];
      if (MODE == 1 && dir == 1) {
#pragma unroll
        for (int m = 0; m < 2; ++m)
#pragma unroll
          for (int j = 0; j < 4; ++j) gl[m][j] = bf2f(p->P[(size_t)(row0 + 16 * m + 4 * fq + j) * INC + 256 + n * 64 + ch]);
      }
      bf16x8 bfr[2][2];
#pragma unroll
      for (int kind = 0; kind < 2; ++kind)
#pragma unroll
        for (int ks = 0; ks < 2; ++ks) bfr[kind][ks] = *(const bf16x8*)(Wn + ((dir * 2 + kind) * 64 + ch) * 72 + 32 * ks + 8 * fq);
      f32x4 acc[2][2];
#pragma unroll
      for (int m = 0; m < 2; ++m)
#pragma unroll
        for (int kind = 0; kind < 2; ++kind) acc[m][kind] = (f32x4){0.f, 0.f, 0.f, 0.f};
#pragma unroll
      for (int m = 0; m < 2; ++m)
#pragma unroll
        for (int ks = 0; ks < 2; ++ks)
#pragma unroll
          for (int kind = 0; kind < 2; ++kind) acc[m][kind] = MFMA16(af[m][ks], bfr[kind][ks], acc[m][kind]);
      const float ba = cst[(dir * 64 + ch) * 3], bx = cst[(dir * 64 + ch) * 3 + 1], ls8 = cst[(dir * 64 + ch) * 3 + 2];
      float a[2][4], bb[2][4];
#pragma unroll
      for (int m = 0; m < 2; ++m)
#pragma unroll
        for (int j = 0; j < 4; ++j) {
          const int t = 16 * m + 4 * fq + j;
          const float r = sigmoidf_(acc[m][0][j] + ba), ig = sigmoidf_(acc[m][1][j] + bx);
          const float la = ls8 * r, x2 = 2.0f * la;
          a[m][j] = __expf(la);
          const float em = -x2 * (1.0f + x2 * (0.5f + x2 * (0.16666667f + x2 * (0.041666668f + x2 * 0.0083333338f))));
          bb[m][j] = __builtin_amdgcn_sqrtf(em) * (ig * bf2f(xcb[t * 72 + ch]));
        }
      float IA[2], IB[2], TA[2], TB[2];
      const int src1 = (dir == 0 ? lane - 16 : lane + 16) & 63, src2 = (dir == 0 ? lane - 32 : lane + 32) & 63;
      const bool v1 = dir == 0 ? fq >= 1 : fq <= 2, v2 = dir == 0 ? fq >= 2 : fq <= 1;
      const int lastl = dir == 0 ? fr + 48 : fr;
#pragma unroll
      for (int m = 0; m < 2; ++m) {
        float A = 1.f, B = 0.f;
#pragma unroll
        for (int jj = 0; jj < 4; ++jj) { const int j = dir == 0 ? jj : 3 - jj; B = a[m][j] * B + bb[m][j]; A = A * a[m][j]; }
        float ua = __shfl(A, src1), ub = __shfl(B, src1);
        if (v1) { B = A * ub + B; A = A * ua; }
        ua = __shfl(A, src2); ub = __shfl(B, src2);
        if (v2) { B = A * ub + B; A = A * ua; }
        IA[m] = A; IB[m] = B;
        TA[m] = __shfl(A, lastl); TB[m] = __shfl(B, lastl);
      }
      const int mf = dir == 0 ? 0 : 1, ms = 1 - mf;
      if (MODE == 0) {
        if (fq == 0) {
          const float A = TA[ms] * TA[mf], B = TA[ms] * TB[mf] + TB[ms];
          float* q = p->aggS + ((size_t)((g * 8 + w) * 2 + dir) * 256 + n * 64 + ch) * 2;
          q[0] = A; q[1] = B;
          aggw[((w * 2 + dir) * 64 + ch) * 2] = A; aggw[((w * 2 + dir) * 64 + ch) * 2 + 1] = B;
        }
      } else {
        const float c = carry[(w * 2 + dir) * 64 + ch];
#pragma unroll
        for (int mi = 0; mi < 2; ++mi) {
          const int m = mi == 0 ? mf : ms;
          const float hin = mi == 0 ? c : TA[mf] * c + TB[mf];
          float ea = __shfl(IA[m], src1), eb = __shfl(IB[m], src1);
          if (!v1) { ea = 1.f; eb = 0.f; }
          float h = ea * hin + eb;
#pragma unroll
          for (int jj = 0; jj < 4; ++jj) {
            const int j = dir == 0 ? jj : 3 - jj;
            h = a[m][j] * h + bb[m][j];
            if (dir == 0) hf[cg][m][j] = h;
            else {
              const float y = hf[cg][m][j] + h, gv = gl[m][j];
              const float u = 0.7978845608028654f * (gv + 0.044715f * gv * gv * gv);
              p->MIX[(size_t)(row0 + 16 * m + 4 * fq + j) * D + n * 64 + ch] = (bf16_t)f2bf(y * gv * sigmoidf_(2.0f * u));
            }
          }
        }
      }
    }
  if (MODE == 0) {
    __syncthreads();
    if (tid < 128) {
      const int dir = tid >> 6, ch = tid & 63;
      float A = 1.f, B = 0.f;
#pragma unroll
      for (int i = 0; i < 8; ++i) { const int w2 = dir == 0 ? i : 7 - i; const float a_ = aggw[((w2 * 2 + dir) * 64 + ch) * 2], b_ = aggw[((w2 * 2 + dir) * 64 + ch) * 2 + 1]; B = a_ * B + b_; A = A * a_; }
      float* q = p->aggG + ((size_t)(g * 2 + dir) * 256 + n * 64 + ch) * 2;
      q[0] = A; q[1] = B;
    }
  }
}

DI void phase_prep(KP p, int l, char* ldsc) {
  const int tid = tid_();
  constexpr int U_TR = 264 * 3, U_LRU = 66 * 4;
#pragma unroll 1
  for (int r = bid_(); r < U_LRU; r += gdim_()) lru_group_unit<0>(p, l, r >> 2, r & 3, ldsc);
#pragma unroll 1
  for (int r = bid_() - 8; r >= 0 && r < U_TR; r += gdim_() - 8) {
    {

      const int chunk = r / 3, cgp = r % 3;
      int row0, b, keypos;
      if (chunk < 256) { b = chunk >> 7; row0 = chunk * 64; keypos = CTXL + (chunk & 127) * 64; }
      else { const int cc = chunk - 256; b = cc >> 2; row0 = TL + cc * 64; keypos = (cc & 3) * 64; }
      const int colbase = cgp < 2 ? 1536 + cgp * 256 : 2560;
      bf16_t* Tt = (bf16_t*)ldsc;
      __syncthreads();
#pragma unroll
      for (int uu = 0; uu < 4; ++uu) {
        const int q = tid + NT * uu, rr = q >> 5, pc = q & 31;
        *(u32x4*)(Tt + rr * 264 + pc * 8) = *(const u32x4*)(p->P + (size_t)(row0 + rr) * INC + colbase + pc * 8);
      }
      __syncthreads();
#pragma unroll
      for (int uu = 0; uu < 4; ++uu) {
        const int q = tid + NT * uu, c = q >> 3, pk = q & 7;
        const bf16_t* s = Tt + (8 * pk) * 264 + c;
        u32x4 o;
        o.x = (unsigned)s[0] | ((unsigned)s[264] << 16); o.y = (unsigned)s[2 * 264] | ((unsigned)s[3 * 264] << 16);
        o.z = (unsigned)s[4 * 264] | ((unsigned)s[5 * 264] << 16); o.w = (unsigned)s[6 * 264] | ((unsigned)s[7 * 264] << 16);
        bf16_t* dst;
        if (cgp < 2) { const int h = cgp * 2 + (c >> 7), dv = c & 127; dst = p->Vtd + ((size_t)((b * 4 + h) * 128 + dv)) * NKEY + keypos + 8 * pk; }
        else { const int h = c >> 6, dv = c & 63; dst = p->Vtn + ((size_t)((b * 4 + h) * 64 + dv)) * NKEY + keypos + 8 * pk; }
        *(u32x4*)dst = o;
      }
    }
  }
}

constexpr float QK_C = 0.125f * 1.4426950408889634f;
constexpr float LOG2E = 1.4426950408889634f;

typedef __attribute__((address_space(3))) unsigned char lds_u8;
typedef __attribute__((address_space(3))) bf16x8 lds_bf16x8;
#define GLDS16(gp, lp) __builtin_amdgcn_global_load_lds((const unsigned*)(gp), (__attribute__((address_space(3))) unsigned*)(lp), 16, 0, 0)
template <int DV, bool LOCAL>
DI void attn_tile(const bf16x8 (&qf)[4], const lds_u8* Kb, const lds_u8* Vb, const int (&ko)[4], const int (&vo)[4], f32x16 (&o)[DV / 32], float& m, float& l, int hh,
                  const float* rpbs, int drow, int cq, int c0) {
  constexpr int ND = DV / 32;
#define ASCHED __builtin_amdgcn_sched_barrier(0)
  f32x16 st[2];
  {
    bf16x8 kf[2][4];
#pragma unroll
    for (int t = 0; t < 2; ++t)
#pragma unroll
      for (int ks = 0; ks < 4; ++ks) kf[t][ks] = *(const lds_bf16x8*)(Kb + ko[ks] + t * 4096);
    ASCHED;
#pragma unroll
    for (int t = 0; t < 2; ++t) {
      f32x16 s;
#pragma unroll
      for (int i = 0; i < 16; ++i) s[i] = 0.f;
#pragma unroll
      for (int ks = 0; ks < 4; ++ks) s = MFMA32(kf[t][ks], qf[ks], s);
      st[t] = s;
    }
  }
  bf16x8 va[2][ND];
#pragma unroll
  for (int s2 = 0; s2 < 2; ++s2)
#pragma unroll
    for (int d = 0; d < ND; ++d) va[s2][d] = *(const lds_bf16x8*)(Vb + vo[s2] + d * 4096);
  ASCHED;
  float mx = -3.0e38f;
  if (LOCAL) {
#pragma unroll
    for (int t = 0; t < 2; ++t)
#pragma unroll
      for (int i = 0; i < 16; ++i) {
        const int ck = 32 * t + 16 * (i >> 3) + 8 * hh + (i & 7);
        const int dc = ck - cq + 15;
        const bool ok = (ck >= c0) && (ck < c0 + 16);
        const int dcc = dc < 0 ? 0 : (dc > 30 ? 30 : dc);
        const float z = ok ? __builtin_fmaf(st[t][i], QK_C, rpbs[drow * 31 + dcc]) : -1.0e30f;
        st[t][i] = z; mx = fmaxf(mx, z);
      }
  } else {
#pragma unroll
    for (int t = 0; t < 2; ++t)
#pragma unroll
      for (int i = 0; i < 16; ++i) mx = fmaxf(mx, st[t][i]);
    mx *= QK_C;
  }
  mx = xhalf_max(mx);
  if (!__all(mx <= m + 8.0f)) {
    const float mn = fmaxf(m, mx);
    const float alpha = __builtin_amdgcn_exp2f(m - mn);
    m = mn; l *= alpha;
#pragma unroll
    for (int d = 0; d < ND; ++d) o[d] *= alpha;
  }
  float ps = 0.f;
#pragma unroll
  for (int t = 0; t < 2; ++t)
#pragma unroll
    for (int i = 0; i < 16; ++i) {
      const float pv = LOCAL ? __builtin_amdgcn_exp2f(st[t][i] - m) : __builtin_amdgcn_exp2f(__builtin_fmaf(st[t][i], QK_C, -m));
      st[t][i] = pv; ps += pv;
    }
  l += ps;
  ASCHED;
  bf16x8 vb[2][ND];
#pragma unroll
  for (int s2 = 0; s2 < 2; ++s2)
#pragma unroll
    for (int d = 0; d < ND; ++d) vb[s2][d] = *(const lds_bf16x8*)(Vb + vo[2 + s2] + d * 4096);
#pragma unroll
  for (int s2 = 0; s2 < 2; ++s2) {
    u32x4 pw;
    pw.x = pk2(st[0][8 * s2 + 0], st[0][8 * s2 + 1]); pw.y = pk2(st[0][8 * s2 + 2], st[0][8 * s2 + 3]);
    pw.z = pk2(st[0][8 * s2 + 4], st[0][8 * s2 + 5]); pw.w = pk2(st[0][8 * s2 + 6], st[0][8 * s2 + 7]);
    const bf16x8 pf = __builtin_bit_cast(bf16x8, pw);
#pragma unroll
    for (int d = 0; d < ND; ++d) o[d] = MFMA32(va[s2][d], pf, o[d]);
  }
  ASCHED;
#pragma unroll
  for (int s2 = 0; s2 < 2; ++s2) {
    u32x4 pw;
    pw.x = pk2(st[1][8 * s2 + 0], st[1][8 * s2 + 1]); pw.y = pk2(st[1][8 * s2 + 2], st[1][8 * s2 + 3]);
    pw.z = pk2(st[1][8 * s2 + 4], st[1][8 * s2 + 5]); pw.w = pk2(st[1][8 * s2 + 6], st[1][8 * s2 + 7]);
    const bf16x8 pf = __builtin_bit_cast(bf16x8, pw);
#pragma unroll
    for (int d = 0; d < ND; ++d) o[d] = MFMA32(vb[s2][d], pf, o[d]);
  }
#undef ASCHED
}

DI void qk_tile(const bf16x8 (&qf)[4], const lds_u8* Kb, const int (&ko)[4], f32x16 (&st)[2]) {
  bf16x8 kf[2][4];
#pragma unroll
  for (int t = 0; t < 2; ++t)
#pragma unroll
    for (int ks = 0; ks < 4; ++ks) kf[t][ks] = *(const lds_bf16x8*)(Kb + ko[ks] + t * 4096);
#pragma unroll
  for (int t = 0; t < 2; ++t) {
    f32x16 s;
#pragma unroll
    for (int i = 0; i < 16; ++i) s[i] = 0.f;
#pragma unroll
    for (int ks = 0; ks < 4; ++ks) s = MFMA32(kf[t][ks], qf[ks], s);
    st[t] = s;
  }
}
DI void pv_grp(f32x16 (&o)[4], const bf16x8 (&v)[4], const bf16x8& Pq) {
#pragma unroll
  for (int d = 0; d < 4; ++d) o[d] = MFMA32(v[d], Pq, o[d]);
}
template <int Q>
DI float exp_pack1(const f32x16 (&st)[2], float m, bf16x8& Pq) {
  float e[8]; float ps = 0.f;
#pragma unroll
  for (int j = 0; j < 8; ++j) { e[j] = __builtin_amdgcn_exp2f(__builtin_fmaf(st[Q >> 1][8 * (Q & 1) + j], QK_C, -m)); ps += e[j]; }
  u32x4 pw; pw.x = pk2(e[0], e[1]); pw.y = pk2(e[2], e[3]); pw.z = pk2(e[4], e[5]); pw.w = pk2(e[6], e[7]);
  Pq = __builtin_bit_cast(bf16x8, pw);
  return ps;
}
DI float exp_pack(const f32x16 (&st)[2], float m, bf16x8 (&Pn)[4]) {
  return (exp_pack1<0>(st, m, Pn[0]) + exp_pack1<1>(st, m, Pn[1])) + (exp_pack1<2>(st, m, Pn[2]) + exp_pack1<3>(st, m, Pn[3]));
}
DI float tile_max(const f32x16 (&st)[2]) {
  float mx = st[0][0];
#pragma unroll
  for (int t = 0; t < 2; ++t)
#pragma unroll
    for (int i = 0; i < 16; ++i) mx = fmaxf(mx, st[t][i]);
  mx *= QK_C;
  return xhalf_max(mx);
}

DI void diff_unit(KP p, int l, int b, int h, int qb, int isctx, float lamv, float lam_init, char* ldsc) {
  const int tid = tid_(), lane = tid & 63, w = __builtin_amdgcn_readfirstlane(tid >> 6), r = lane & 31, hh = lane >> 5;
  const int pr = (r & ~12) | ((r & 4) << 1) | ((r & 8) >> 1);
  const int comp = w & 1, grp = w >> 1;
  const int qrow = (isctx ? TL + b * CTXL : b * SEQ) + qb * 128 + grp * 32 + r;
  const int nt = isctx ? 4 : 132;
  lds_u8* L = (lds_u8*)ldsc;
  constexpr int STG = 32768;
  int ko[4], vo[4];
#pragma unroll
  for (int ks = 0; ks < 4; ++ks) ko[ks] = pr * 128 + (((2 * ks + hh) ^ ((pr >> 1) & 7)) << 4);
#pragma unroll
  for (int q = 0; q < 4; ++q) vo[q] = r * 128 + (((2 * q + hh) ^ ((r >> 1) & 7)) << 4);
  bf16x8 qf[4];
#pragma unroll
  for (int ks = 0; ks < 4; ++ks) qf[ks] = *(const bf16x8*)(p->P + (size_t)qrow * INC + 512 + h * 128 + comp * 64 + 16 * ks + 8 * hh);
  f32x16 o[4];
#pragma unroll
  for (int d = 0; d < 4; ++d)
#pragma unroll
    for (int i = 0; i < 16; ++i) o[d][i] = 0.f;
  float m, lsum;
  const bf16_t* vt = p->Vtd + (size_t)((b * 4 + h) * 128) * NKEY;
  const bf16_t* Pk = p->P + 1024 + h * 128;
  const int row8 = 8 * w + (lane >> 3), swz = ((lane & 7) ^ ((row8 >> 1) & 7)) << 4;
  const unsigned kq = (unsigned)(row8 * (INC * 2) + swz), vq = (unsigned)(row8 * (NKEY * 2) + swz);
#define DISSUE(kt, stg) do { const int krow_ = (kt) < 4 ? TL + b * CTXL + (kt) * 64 : b * SEQ + ((kt) - 4) * 64; \
    const char* kb_ = (const char*)(Pk + (size_t)krow_ * INC) + kq; const char* vb_ = (const char*)(vt + (kt) * 64) + vq; \
    lds_u8* sb_ = L + (stg) * STG + w * 1024; \
    GLDS16(kb_, sb_); GLDS16(kb_ + 128, sb_ + 8192); GLDS16(vb_, sb_ + 16384); GLDS16(vb_ + (size_t)64 * NKEY * 2, sb_ + 24576); } while (0)
#define VLOAD(dst, sbv, q) do { _Pragma("unroll") for (int d_ = 0; d_ < 4; ++d_) dst[d_] = *(const lds_bf16x8*)((sbv) + vo[q] + d_ * 4096); } while (0)
  asm volatile("s_waitcnt vmcnt(0)" ::: "memory");
  __syncthreads();
  DISSUE(0, 0);
  DISSUE(1, 1);
  asm volatile("s_waitcnt vmcnt(4)" ::: "memory");
  __builtin_amdgcn_s_barrier();
  bf16x8 P[4];
  {
    f32x16 st[2];
    qk_tile(qf, L + comp * 8192, ko, st);
    m = tile_max(st);
    lsum = exp_pack(st, m, P);
  }
  int stg = 0;
  bool need = false; float alpha = 1.f;
  if (w >= 4) __builtin_amdgcn_s_setprio(1);
  bf16x8 vA[4], vB[4];
  VLOAD(vA, L + 16384, 0); VLOAD(vB, L + 16384, 1);
#define FENCE __builtin_amdgcn_sched_barrier(0)
#pragma unroll 1
  for (int kt = 0; kt < nt - 1; ++kt) {
    asm volatile("s_waitcnt vmcnt(0)" ::: "memory");
    __builtin_amdgcn_s_barrier();
    const int stg1 = stg == 2 ? 0 : stg + 1;
    if (kt + 2 < nt) { const int s2_ = stg >= 1 ? stg - 1 : 2; DISSUE(kt + 2, s2_); }
    if (need) {
#pragma unroll
      for (int d = 0; d < 4; ++d) o[d] *= alpha;
    }
    const lds_u8* sbv = L + stg * STG + 16384;
    const lds_u8* sbk = L + stg1 * STG + comp * 8192;
    bf16x8 kf[2][4];
    f32x16 st[2];
#pragma unroll
    for (int t = 0; t < 2; ++t)
#pragma unroll
      for (int ks = 0; ks < 4; ++ks) kf[t][ks] = *(const lds_bf16x8*)(sbk + ko[ks] + t * 4096);
    FENCE;
    pv_grp(o, vA, P[0]); pv_grp(o, vB, P[1]);
    VLOAD(vA, sbv, 2); VLOAD(vB, sbv, 3);
    FENCE;
#pragma unroll
    for (int i = 0; i < 16; ++i) { st[0][i] = 0.f; st[1][i] = 0.f; }
#pragma unroll
    for (int ks = 0; ks < 4; ++ks) st[0] = MFMA32(kf[0][ks], qf[ks], st[0]);
#pragma unroll
    for (int ks = 0; ks < 4; ++ks) st[1] = MFMA32(kf[1][ks], qf[ks], st[1]);
    FENCE;
    pv_grp(o, vA, P[2]);
    const float mx = tile_max(st);
    need = !__all(mx <= m + 8.0f);
    const float mn = need ? fmaxf(m, mx) : m;
    alpha = __builtin_amdgcn_exp2f(m - mn);
    FENCE;
    float ps = exp_pack1<0>(st, mn, P[0]);
    ps += exp_pack1<1>(st, mn, P[1]);
    ps += exp_pack1<2>(st, mn, P[2]);
    pv_grp(o, vB, P[3]);
    ps += exp_pack1<3>(st, mn, P[3]);
#pragma unroll
    for (int q = 0; q < 4; ++q) { __builtin_amdgcn_sched_group_barrier(0x402, 18, 0); __builtin_amdgcn_sched_group_barrier(0x008, 1, 0); }
    lsum = lsum * alpha + ps; m = mn;
    FENCE;
    { const lds_u8* sbn = L + stg1 * STG + 16384; VLOAD(vA, sbn, 0); VLOAD(vB, sbn, 1); }
    stg = stg1;
  }
  __builtin_amdgcn_s_setprio(0);
  if (need) {
#pragma unroll
    for (int d = 0; d < 4; ++d) o[d] *= alpha;
  }
  {
    const lds_u8* sbv = L + stg * STG + 16384;
    pv_grp(o, vA, P[0]); pv_grp(o, vB, P[1]);
    VLOAD(vA, sbv, 2); VLOAD(vB, sbv, 3);
    pv_grp(o, vA, P[2]);
    pv_grp(o, vB, P[3]);
  }
#undef FENCE
#undef DISSUE
#undef VLOAD
  __syncthreads();
  const float ltot = lsum + __shfl_xor(lsum, 32);
  const float inv = 1.0f / ltot;
  float* Ob = (float*)ldsc + grp * 4096 + lane;
  if (comp == 1) {
#pragma unroll
    for (int d = 0; d < 4; ++d)
#pragma unroll
      for (int i = 0; i < 16; ++i) Ob[(d * 16 + i) * 64] = o[d][i] * inv;
  }
  __syncthreads();
  if (comp == 0) {
    float ss = 0.f;
#pragma unroll
    for (int d = 0; d < 4; ++d)
#pragma unroll
      for (int i = 0; i < 16; ++i) { const float v = o[d][i] * inv - lamv * Ob[(d * 16 + i) * 64]; o[d][i] = v; ss += v * v; }
    ss += __shfl_xor(ss, 32);
    const float sc = (1.0f - lam_init) / sqrtf(ss * (1.0f / 128.0f) + 1e-6f);
    const float* sg = p->subln_g + l * 128;
    bf16_t* mrow = p->MIX + (size_t)qrow * D + 256 + h * 128;
#pragma unroll
    for (int d = 0; d < 4; ++d)
#pragma unroll
      for (int i4 = 0; i4 < 4; ++i4) {
        const int dv = 32 * d + 8 * i4 + 4 * hh;
        const f32x4 gv = *(const f32x4*)(sg + dv);
        u32x2 ov; ov.x = pk2(o[d][4 * i4 + 0] * sc * gv[0], o[d][4 * i4 + 1] * sc * gv[1]); ov.y = pk2(o[d][4 * i4 + 2] * sc * gv[2], o[d][4 * i4 + 3] * sc * gv[3]);
        *(u32x2*)(mrow + dv) = ov;
      }
  }
}

DI void na_unit(KP p, int l, int b, int h, int rb, int isctx, char* ldsc) {
  const int tid = tid_(), lane = tid & 63, w = __builtin_amdgcn_readfirstlane(tid >> 6), r = lane & 31, hh = lane >> 5;
  const int pr = (r & ~12) | ((r & 4) << 1) | ((r & 8) >> 1);
  const int rq0 = rb * 4, rq = rq0 + (w >> 1), cq = (w & 1) * 32 + r;
  const int qrow = isctx ? TL + b * CTXL + w * 32 + r : b * SEQ + rq * 64 + cq;
  const int r0w = min(max(rq - 4, 0), 120);
  const int c0 = min(max(cq - 8, 0), 48);
  const int rlo = min(max(rq0 - 4, 0), 120), rhi = min(max(rq0 + 3 - 4, 0), 120) + 7;
  const int nt = isctx ? 4 : 4 + (rhi - rlo + 1);
  lds_u8* L = (lds_u8*)ldsc;
  float* rpbs = (float*)(ldsc + LDS_CONST + 64);
  constexpr int STG = 16384;
  int ko[4], vo[4];
#pragma unroll
  for (int ks = 0; ks < 4; ++ks) ko[ks] = pr * 128 + (((2 * ks + hh) ^ ((pr >> 1) & 7)) << 4);
#pragma unroll
  for (int q = 0; q < 4; ++q) vo[q] = r * 128 + (((2 * q + hh) ^ ((r >> 1) & 7)) << 4);
  asm volatile("s_waitcnt vmcnt(0)" ::: "memory");
  __syncthreads();
  if (!isctx) for (int e = tid; e < 465; e += NT) rpbs[e] = p->rpb[(size_t)(l * 4 + h) * 465 + e] * LOG2E;
  bf16x8 qf[4];
#pragma unroll
  for (int ks = 0; ks < 4; ++ks) qf[ks] = *(const bf16x8*)(p->P + (size_t)qrow * INC + 2048 + h * 64 + 16 * ks + 8 * hh);
  f32x16 o[2];
#pragma unroll
  for (int d = 0; d < 2; ++d)
#pragma unroll
    for (int i = 0; i < 16; ++i) o[d][i] = 0.f;
  float m = -3.0e38f, lsum = 0.f;
  const bf16_t* vt = p->Vtn + (size_t)((b * 4 + h) * 64) * NKEY;
  const bf16_t* Pk = p->P + 2304 + h * 64;
  const int row8 = 8 * w + (lane >> 3), swz = ((lane & 7) ^ ((row8 >> 1) & 7)) << 4;
  const unsigned kq = (unsigned)(row8 * (INC * 2) + swz), vq = (unsigned)(row8 * (NKEY * 2) + swz);
#define NISSUE(kt, stg) do { const int kr_ = (kt) < 4 ? TL + b * CTXL + (kt) * 64 : b * SEQ + (rlo + (kt) - 4) * 64; const int kp_ = (kt) < 4 ? (kt) * 64 : CTXL + (rlo + (kt) - 4) * 64; \
    lds_u8* sb_ = L + (stg) * STG + w * 1024; \
    GLDS16((const char*)(Pk + (size_t)kr_ * INC) + kq, sb_); GLDS16((const char*)(vt + kp_) + vq, sb_ + 8192); } while (0)
  asm volatile("s_waitcnt vmcnt(0)" ::: "memory");
  NISSUE(0, 0);
  NISSUE(1, 1);
  int stg = 0;
#pragma unroll 1
  for (int kt = 0; kt < nt; ++kt) {
    if (kt + 1 < nt) asm volatile("s_waitcnt vmcnt(2)" ::: "memory"); else asm volatile("s_waitcnt vmcnt(0)" ::: "memory");
    asm volatile("s_waitcnt lgkmcnt(0)" ::: "memory");
    __builtin_amdgcn_s_barrier();
    if (kt + 2 < nt) { const int s2_ = stg >= 1 ? stg - 1 : 2; NISSUE(kt + 2, s2_); }
    const lds_u8* sb = L + stg * STG;
    if (kt < 4) attn_tile<64, false>(qf, sb, sb + 8192, ko, vo, o, m, lsum, hh, nullptr, 0, 0, 0);
    else {
      const int rk = rlo + kt - 4;
      if (rk >= r0w && rk < r0w + 8) attn_tile<64, true>(qf, sb, sb + 8192, ko, vo, o, m, lsum, hh, rpbs, rk - rq + 7, cq, c0);
    }
    stg = stg == 2 ? 0 : stg + 1;
  }
#undef NISSUE
  const float ltot = lsum + __shfl_xor(lsum, 32);
  const float inv = 1.0f / ltot;
  bf16_t* mrow = p->MIX + (size_t)qrow * D + 768 + h * 64;
#pragma unroll
  for (int d = 0; d < 2; ++d)
#pragma unroll
    for (int i4 = 0; i4 < 4; ++i4) {
      const int dv = 32 * d + 8 * i4 + 4 * hh;
      u32x2 ov; ov.x = pk2(o[d][4 * i4 + 0] * inv, o[d][4 * i4 + 1] * inv); ov.y = pk2(o[d][4 * i4 + 2] * inv, o[d][4 * i4 + 3] * inv);
      *(u32x2*)(mrow + dv) = ov;
    }
}

DI void phase_attn(KP p, int l, char* ldsc) {
  const bool last = l == DEPTH - 1;
  const float lam_init = 0.8f - 0.6f * expf(-0.3f * (float)l);
  float* cst = (float*)(ldsc + LDS_CONST);
  __syncthreads();
  if (tid_() < 64) {
    const float* dl = p->diff_lam + l * 256;
    const int i = tid_();
    const float s1 = wave_sum(dl[i] * dl[64 + i]), s2 = wave_sum(dl[128 + i] * dl[192 + i]);
    if (i == 0) cst[0] = expf(s1) - expf(s2) + lam_init;
  }
  __syncthreads();
  const float lamv = cst[0];
  const int nb = gdim_(), bid = bid_();
#pragma unroll 1
  for (int r = bid; r < 512; r += nb) diff_unit(p, l, r >> 8, (r >> 6) & 3, r & 63, 0, lamv, lam_init, ldsc);
#if PROBE_DUP == 6
#pragma unroll 1
  for (int r = bid; r < 512; r += nb) diff_unit(p, l, r >> 8, (r >> 6) & 3, r & 63, 0, lamv, lam_init, ldsc);
#endif
#pragma unroll 1
  for (int r = bid; r < 256; r += nb) na_unit(p, l, r >> 7, (r >> 5) & 3, r & 31, 0, ldsc);
#pragma unroll 1
  for (int r = bid; r < (last ? 64 : 66) * 4; r += nb) lru_group_unit<1>(p, l, r >> 2, r & 3, ldsc);
#if PROBE_DUP == 4
#pragma unroll 1
  for (int r = bid; r < (last ? 64 : 66) * 4; r += nb) lru_group_unit<1>(p, l, r >> 2, r & 3, ldsc);
#endif
#if PROBE_DUP == 5
#pragma unroll 1
  for (int r = bid; r < 256; r += nb) na_unit(p, l, r >> 7, (r >> 5) & 3, r & 31, 0, ldsc);
#endif
  if (!last) {
#pragma unroll 1
    for (int r = nb - 1 - bid; r < 16; r += nb) diff_unit(p, l, r >> 3, (r >> 1) & 3, r & 1, 1, lamv, lam_init, ldsc);
#pragma unroll 1
    for (int r = nb - 17 - bid; r >= 0 && r < 8; r += nb) na_unit(p, l, r >> 2, r & 3, 0, 1, ldsc);
  }
}

__global__ void __launch_bounds__(512) mega(Params pv) {
  extern __shared__ __attribute__((aligned(16))) char lds[];
  cg::grid_group grid = cg::this_grid();
  volatile LAS unsigned* xst = (volatile LAS unsigned*)((LAS char*)lds + 131072);
  if (threadIdx.x == 0) { xst[0] = 0u; xst[1] = 0u; xst[2] = 0u; xst[3] = 0u; }
  __syncthreads();
  (void)xcd_barrier_post(get_params()->bar, xst);
#define XBAR() do { XcdBarrier xb_; xb_.bar = get_params()->bar; xb_.x = xb_xcc_id(); xb_.st = (volatile LAS unsigned*)((LAS char*)lds + 131072); xcd_barrier(xb_); } while (0)
  phase_prologue(get_params(), lds);
  if (gridDim.x == 0x7fffffffu) grid.sync();
  XBAR();
#pragma unroll 1
  for (int l = 0; l < DEPTH; ++l) {
    const bool last = l == DEPTH - 1;
    const int Mr = last ? TL : T;
    { KP p = get_params(); phase_norm(p, p->norm1_g + l * D, p->mods + (size_t)l * 3 * 6144, 0, 1, T, l ? p->X : p->x, l ? p->X + (size_t)TL * D : p->ctx); }
    XBAR();
#if PROBE_DUP == 2
    { KP p = get_params(); GemmArgs g; g.A = p->H; g.Bt = p->Win_t + (size_t)l * INC * D; g.M = T; g.N = INC; g.K = D; g.ctx = 0; g.mode = 0; g.Ob = p->P; g.X = nullptr; g.gate = nullptr; g.rope = p->rope; g.Xlat = nullptr; g.Xctx = nullptr; gemm_phase(g, lds); }
    XBAR();
#endif
    { KP p = get_params(); GemmArgs g; g.A = p->H; g.Bt = p->Win_t + (size_t)l * INC * D; g.M = T; g.N = INC; g.K = D; g.ctx = 0; g.mode = 0; g.Ob = p->P; g.X = nullptr; g.gate = nullptr; g.rope = p->rope; g.Xlat = nullptr; g.Xctx = nullptr; gemm_phase(g, lds); }
    XBAR();
    phase_prep(get_params(), l, lds);
    XBAR();
    phase_attn(get_params(), l, lds);
    XBAR();
#if PROBE_DUP == 1
    phase_attn(get_params(), l, lds);
    XBAR();
#endif
#if PROBE_DUP == 2
    { KP p = get_params(); GemmArgs g; g.A = p->MIX; g.Bt = p->Wout_t + (size_t)l * D * D; g.M = Mr; g.N = D; g.K = D; g.ctx = 0; g.mode = 0; g.Ob = p->P; g.X = nullptr; g.gate = nullptr; g.rope = nullptr; g.Xlat = nullptr; g.Xctx = nullptr; gemm_phase(g, lds); }
    XBAR();
#endif
    { KP p = get_params(); GemmArgs g; g.A = p->MIX; g.Bt = p->Wout_t + (size_t)l * D * D; g.M = TL; g.ctx = !last; g.N = D; g.K = D; g.mode = 1; g.Ob = nullptr; g.X = p->X; g.gate = p->mods + (size_t)l * 3 * 6144 + 2 * 1024; g.rope = nullptr; g.Xlat = l ? p->X : p->x; g.Xctx = l ? p->X + (size_t)TL * D : p->ctx; gemm_phase(g, lds); }
    XBAR();
    { KP p = get_params(); phase_norm(p, p->norm2_g + l * D, p->mods + (size_t)l * 3 * 6144, 3, 4, Mr, p->X, p->X + (size_t)TL * D); }
    XBAR();
#if PROBE_DUP == 2
    { KP p = get_params(); GemmArgs g; g.A = p->H; g.Bt = p->Wgu_t + (size_t)l * 2 * FFH * D; g.M = Mr; g.N = 2 * FFH; g.K = D; g.ctx = 0; g.mode = 2; g.Ob = p->P; g.X = nullptr; g.gate = nullptr; g.rope = nullptr; g.Xlat = nullptr; g.Xctx = nullptr; gemm_phase(g, lds); }
    XBAR();
#endif
    { KP p = get_params(); GemmArgs g; g.A = p->H; g.Bt = p->Wgu_t + (size_t)l * 2 * FFH * D; g.M = Mr; g.N = 2 * FFH; g.K = D; g.ctx = 0; g.mode = 2; g.Ob = p->P; g.X = nullptr; g.gate = nullptr; g.rope = nullptr; g.Xlat = nullptr; g.Xctx = nullptr; gemm_phase(g, lds); }
    XBAR();
#if PROBE_DUP == 2
    { KP p = get_params(); GemmArgs g; g.A = p->P; g.Bt = p->Wdown_t + (size_t)l * D * FFH; g.M = Mr; g.N = D; g.K = FFH; g.ctx = 0; g.mode = 0; g.Ob = p->MIX; g.X = nullptr; g.gate = nullptr; g.rope = nullptr; g.Xlat = nullptr; g.Xctx = nullptr; gemm_phase(g, lds); }
    XBAR();
#endif
    { KP p = get_params(); GemmArgs g; g.A = p->P; g.Bt = p->Wdown_t + (size_t)l * D * FFH; g.M = TL; g.ctx = !last; g.N = D; g.K = FFH; g.mode = 1; g.Ob = nullptr; g.X = p->X; g.gate = p->mods + (size_t)l * 3 * 6144 + 5 * 1024; g.rope = nullptr; g.Xlat = p->X; g.Xctx = p->X + (size_t)TL * D; gemm_phase(g, lds); }
    XBAR();
  }
  phase_final(get_params());
}

extern "C" void kernel_launch(void* const* d_in, const int* in_sizes, int n_in, void* d_out, int out_size, void* d_ws, size_t ws_size, hipStream_t stream) {
  static int grid_blocks = 0;
  if (!grid_blocks) {
    int dev = 0, cus = 0, per_cu = 0;
    hipGetDevice(&dev);
    hipDeviceGetAttribute(&cus, hipDeviceAttributeMultiprocessorCount, dev);
    hipFuncSetAttribute((const void*)mega, hipFuncAttributeMaxDynamicSharedMemorySize, LDS_BYTES);
    hipOccupancyMaxActiveBlocksPerMultiprocessor(&per_cu, (const void*)mega, NT, LDS_BYTES);
    if (per_cu < 1) per_cu = 1;
    grid_blocks = cus * per_cu;
  }
  Params p{};
  const float* const* in = (const float* const*)d_in;
  p.x = in[0]; p.c = in[1]; p.ctx = in[2]; p.c_ctx = in[3]; p.w_mod = in[4]; p.b_mod = in[5]; p.norm1_g = in[6]; p.norm2_g = in[7]; p.w_in = in[8];
  p.conv_w = in[9]; p.conv_b = in[10]; p.lru_wa = in[11]; p.lru_ba = in[12]; p.lru_wx = in[13]; p.lru_bx = in[14]; p.lru_lam = in[15]; p.diff_lam = in[16];
  p.subln_g = in[17]; p.rpb = in[18]; p.w_out = in[19]; p.w_gu = in[20]; p.w_down = in[21]; p.final_g = in[22];
  p.out = (float*)d_out;
  char* ws = (char*)d_ws; size_t off = 0;
  auto take = [&](size_t bytes) { char* q = ws + off; off += (bytes + 255) & ~(size_t)255; return q; };
  p.Win_t = (bf16_t*)take((size_t)DEPTH * INC * D * 2);
  p.Wout_t = (bf16_t*)take((size_t)DEPTH * D * D * 2);
  p.Wgu_t = (bf16_t*)take((size_t)DEPTH * 2 * FFH * D * 2);
  p.Wdown_t = (bf16_t*)take((size_t)DEPTH * D * FFH * 2);
  p.Wl = (bf16_t*)take((size_t)64 * 4096 * 2);
  p.X = (float*)take((size_t)T * D * 4);
  p.H = (bf16_t*)take((size_t)T * D * 2);
  p.P = (bf16_t*)take((size_t)T * INC * 2);
  p.MIX = (bf16_t*)take((size_t)T * D * 2);
  p.Vtd = (bf16_t*)take((size_t)NBATCH * 4 * 128 * NKEY * 2);
  p.Vtn = (bf16_t*)take((size_t)NBATCH * 4 * 64 * NKEY * 2);
  p.mods = (float*)take((size_t)DEPTH * 3 * 6144 * 4);
  p.rope = (float*)take((size_t)128 * 16 * 2 * 4);
  p.aggS = (float*)take((size_t)66 * 8 * 2 * 256 * 2 * 4);
  p.aggG = (float*)take((size_t)66 * 2 * 256 * 2 * 4);
  p.bar = (unsigned*)take((size_t)XCD_BAR_WORDS * 4);
  if (off > ws_size) { fprintf(stderr, "kernel_launch: workspace too small: need %zu have %zu\n", off, ws_size); return; }
  if (hipMemsetAsync(p.bar, 0, (size_t)XCD_BAR_WORDS * 4, stream) != hipSuccess) { fprintf(stderr, "kernel_launch: memset of barrier words failed\n"); return; }
  void* args[] = {&p};
  hipError_t e = hipLaunchCooperativeKernel((void*)mega, dim3(grid_blocks), dim3(NT), args, LDS_BYTES, stream);
  if (e != hipSuccess) fprintf(stderr, "cooperative launch failed: %s (grid %d)\n", hipGetErrorString(e), grid_blocks);
}
```

```cpp
#include <hip/hip_runtime.h>
#include <hip/hip_cooperative_groups.h>
#include <cstdio>
#include <cstdint>
namespace cg = cooperative_groups;
#ifndef PROBE_DUP
#define PROBE_DUP 0
#endif

typedef unsigned short bf16_t;
typedef short bf16x8 __attribute__((ext_vector_type(8)));
typedef float f32x4 __attribute__((ext_vector_type(4)));
typedef float f32x16 __attribute__((ext_vector_type(16)));
typedef unsigned u32x4 __attribute__((ext_vector_type(4)));
typedef unsigned u32x2 __attribute__((ext_vector_type(2)));

#define DI __device__ __forceinline__
#define MFMA32(a, b, c) __builtin_amdgcn_mfma_f32_32x32x16_bf16((a), (b), (c), 0, 0, 0)
#define MFMA16(a, b, c) __builtin_amdgcn_mfma_f32_16x16x32_bf16((a), (b), (c), 0, 0, 0)

constexpr int D = 1024, SEQ = 8192, NBATCH = 2, DEPTH = 4, CTXL = 256;
constexpr int TL = NBATCH * SEQ, TC = NBATCH * CTXL, T = TL + TC;
constexpr int INC = 2816, FFH = 2816, NKEY = CTXL + SEQ;
constexpr int LDS_BYTES = 131072 + 16;
constexpr int LDS_CONST = 122880;
constexpr int NT = 512;

struct Params {
  const float *x, *c, *ctx, *c_ctx, *w_mod, *b_mod, *norm1_g, *norm2_g, *w_in, *conv_w, *conv_b, *lru_wa, *lru_ba, *lru_wx, *lru_bx,
      *lru_lam, *diff_lam, *subln_g, *rpb, *w_out, *w_gu, *w_down, *final_g;
  float* out;
  bf16_t *Win_t, *Wout_t, *Wgu_t, *Wdown_t, *Wl;
  float* X;
  bf16_t *H, *P, *MIX, *Vtd, *Vtn;
  float *mods, *rope, *aggS, *aggG;
  unsigned* bar;
};

typedef const __attribute__((address_space(4))) Params* KP;
DI KP get_params() { KP kp = (KP)__builtin_amdgcn_kernarg_segment_ptr(); asm volatile("" : "+s"(kp)); return kp; }

#define XB_TMO      128
#define XB_XCNT(j)  (256  + 64 * (j))
#define XB_XSUB(j)  (1280 + 64 * (j))
#define XB_XGEN(j)  (2304 + 64 * (j))
#define XB_TOP      3328
#define XB_TOPGEN   3392
#define XCD_BAR_WORDS 3456
#define XB_SPIN_CAP (1u << 22)
#define LAS __attribute__((address_space(3)))
DI unsigned xb_ld(unsigned* p)              { return __hip_atomic_load(p, __ATOMIC_RELAXED, __HIP_MEMORY_SCOPE_AGENT); }
DI unsigned xb_add(unsigned* p, unsigned v) { return __hip_atomic_fetch_add(p, v, __ATOMIC_RELAXED, __HIP_MEMORY_SCOPE_AGENT); }
DI unsigned xb_xcc_id() { return (unsigned)__builtin_amdgcn_s_getreg((3 << 11) | 20) & 0xFu; }
#define XB_SPIN(cond, bar) do { unsigned _sp = 0; while (cond) { __builtin_amdgcn_s_sleep(1); \
    if ((++_sp & 255u) == 0u) { if (xb_ld(&(bar)[XB_TMO])) break; if (_sp > XB_SPIN_CAP) { atomicAdd(&(bar)[XB_TMO], 1u); break; } } } } while (0)
struct XcdBarrier { unsigned* bar; unsigned x; volatile LAS unsigned* st; };
DI XcdBarrier xcd_barrier_post(unsigned* bar, volatile LAS unsigned* st) {
  XcdBarrier b; b.bar = bar; b.x = xb_xcc_id(); b.st = st;
  if (threadIdx.x == 0) (void)xb_add(&bar[XB_XCNT(b.x)], 1u);
  return b;
}
DI void xcd_barrier_complete(unsigned* bar, unsigned x, unsigned& nloc, unsigned& nx) {
  const unsigned G = gridDim.x * gridDim.y * gridDim.z;
  unsigned sum, cnt, mine, sp = 0u;
  for (;;) {
    sum = 0u; cnt = 0u; mine = 0u;
#pragma unroll
    for (unsigned j = 0; j < 16; ++j) { const unsigned c = xb_ld(&bar[XB_XCNT(j)]); sum += c; cnt += (c > 0u) ? 1u : 0u; mine = (j == x) ? c : mine; }
    if (sum == G) break;
    __builtin_amdgcn_s_sleep(1);
    if ((++sp & 255u) == 0u) { if (xb_ld(&bar[XB_TMO])) break; if (sp > XB_SPIN_CAP) { atomicAdd(&bar[XB_TMO], 1u); break; } }
  }
  nloc = mine > 0u ? mine : 1u; nx = cnt > 0u ? cnt : 1u;
}
DI void xcd_barrier(const XcdBarrier& b) {
  asm volatile("s_waitcnt vmcnt(0)" ::: "memory");
  __syncthreads();
  if (threadIdx.x == 0) {
    unsigned* bar = b.bar;
    __builtin_amdgcn_s_waitcnt(0);
    unsigned nloc = b.st[0], nx = b.st[1];
    if (nloc == 0u) { xcd_barrier_complete(bar, b.x, nloc, nx); b.st[0] = nloc; b.st[1] = nx; }
    const unsigned old = xb_add(&bar[XB_XSUB(b.x)], 1u);
    const unsigned gen = old / nloc;
    if (old + 1u == (gen + 1u) * nloc) {
      __builtin_amdgcn_fence(__ATOMIC_RELEASE, "agent");
      asm volatile("s_waitcnt vmcnt(0)" ::: "memory");
      const unsigned og = xb_add(&bar[XB_TOP], 1u);
      const unsigned tg = og / nx;
      if (og + 1u == (tg + 1u) * nx) xb_add(&bar[XB_TOPGEN], 1u);
      else XB_SPIN(xb_ld(&bar[XB_TOPGEN]) == tg, bar);
      __builtin_amdgcn_fence(__ATOMIC_ACQUIRE, "agent");
      xb_add(&bar[XB_XGEN(b.x)], 1u);
      asm volatile("s_waitcnt vmcnt(0)" ::: "memory");
    } else {
      XB_SPIN(xb_ld(&bar[XB_XGEN(b.x)]) == gen, bar);
      __builtin_amdgcn_fence(__ATOMIC_ACQUIRE, "agent");
      asm volatile("s_waitcnt vmcnt(0)" ::: "memory");
    }
  }
  __syncthreads();
}

DI int tid_() { int t = threadIdx.x; asm volatile("" : "+v"(t)); return t; }
DI int bid_() { int b = blockIdx.x; asm volatile("" : "+s"(b)); return b; }
DI int gdim_() { int g = gridDim.x; asm volatile("" : "+s"(g)); return g; }

DI unsigned f2bf(float x) { unsigned u = __float_as_uint(x); u += 0x7fffu + ((u >> 16) & 1u); return u >> 16; }
typedef __bf16 bf16v2_t __attribute__((ext_vector_type(2)));
typedef float f32x2 __attribute__((ext_vector_type(2)));
DI unsigned pk2(float lo, float hi) { f32x2 v = {lo, hi}; bf16v2_t b = __builtin_convertvector(v, bf16v2_t); return __builtin_bit_cast(unsigned, b); }
DI float bf2f(bf16_t v) { return __uint_as_float(((unsigned)v) << 16); }
DI float wave_sum(float v) {
#pragma unroll
  for (int o = 1; o < 64; o <<= 1) v += __shfl_xor(v, o);
  return v;
}
DI float xhalf_max(float v) { const auto r = __builtin_amdgcn_permlane32_swap(__float_as_uint(v), __float_as_uint(v), false, false); return fmaxf(__uint_as_float(r[0]), __uint_as_float(r[1])); }
DI float sigmoidf_(float x) { return __builtin_amdgcn_rcpf(1.f + __expf(-x)); }
DI float gelu_tanh(float x) { const float u = 0.7978845608028654f * (x + 0.044715f * x * x * x); return 0.5f * x * (1.f + tanhf(u)); }

DI void wt_unit(const float* W, int K, int N, bf16_t* WT, int kt, int ntile, bool gu, float* scr  ) {
  const int tid = tid_(), k0 = kt * 64, n0 = ntile * 128;
  __syncthreads();
  {
    const int n = tid & 127, kq = tid >> 7;
#pragma unroll 4
    for (int i = 0; i < 16; ++i) { const int k = kq * 16 + i; scr[k * 129 + n] = W[(size_t)(k0 + k) * N + n0 + n]; }
  }
  __syncthreads();
  {
    const int n = tid >> 2, kq = tid & 3;
    const float* s = scr + (kq * 16) * 129 + n;
    u32x4 o0, o1;
    o0.x = pk2(s[0 * 129], s[1 * 129]); o0.y = pk2(s[2 * 129], s[3 * 129]); o0.z = pk2(s[4 * 129], s[5 * 129]); o0.w = pk2(s[6 * 129], s[7 * 129]);
    o1.x = pk2(s[8 * 129], s[9 * 129]); o1.y = pk2(s[10 * 129], s[11 * 129]); o1.z = pk2(s[12 * 129], s[13 * 129]); o1.w = pk2(s[14 * 129], s[15 * 129]);
    const int nsrc = n0 + n;
    int ndst = nsrc;
    if (gu) { const int sel = nsrc < FFH ? 0 : 1; const int j = nsrc - sel * FFH; ndst = (j >> 4) * 32 + sel * 16 + (j & 15); }
    bf16_t* d = WT + (size_t)ndst * K + k0 + kq * 16;
    *(u32x4*)d = o0; *(u32x4*)(d + 8) = o1;
  }
}

DI void mods_unit(KP p, int l, int cb, float* lds) {
  const int tid = tid_();
  float* cond = lds;
  float* red = lds + 3072;
  __syncthreads();
  for (int i = tid; i < 3072; i += NT) { const int v = i >> 10, k = i & 1023; const float c = v < 2 ? p->c[v * 1024 + k] : p->c_ctx[k]; cond[i] = c / (1.f + __expf(-c)); }
  __syncthreads();
  const int c4 = tid & 31, kg = tid >> 5;
  f32x4 a0 = {0.f, 0.f, 0.f, 0.f}, a1 = a0, a2 = a0;
  const float* w = p->w_mod + (size_t)l * 1024 * 6144 + cb * 128 + c4 * 4;
#pragma unroll 8
  for (int k = kg * 64; k < kg * 64 + 64; ++k) { const f32x4 wv = *(const f32x4*)(w + (size_t)k * 6144); a0 += wv * cond[k]; a1 += wv * cond[1024 + k]; a2 += wv * cond[2048 + k]; }
  *(f32x4*)(red + (kg * 3 + 0) * 128 + c4 * 4) = a0; *(f32x4*)(red + (kg * 3 + 1) * 128 + c4 * 4) = a1; *(f32x4*)(red + (kg * 3 + 2) * 128 + c4 * 4) = a2;
  __syncthreads();
  if (tid < 384) {
    const int v = tid >> 7, c2 = tid & 127;
    float s_ = 0.f;
#pragma unroll
    for (int q = 0; q < 16; ++q) s_ += red[(q * 3 + v) * 128 + c2];
    p->mods[(size_t)(l * 3 + v) * 6144 + cb * 128 + c2] = s_ + p->b_mod[l * 6144 + cb * 128 + c2];
  }
}

DI void phase_prologue(KP p, char* ldsc) {
  const int tid = tid_(), nb = gdim_(), bid = bid_();
  float* lds = (float*)ldsc;
  constexpr int U_MODS = DEPTH * 48, U_IN = 16 * 22, U_OUT = 16 * 8, U_GU = 16 * 44, U_DN = 44 * 8, U_WL = U_IN + U_OUT + U_GU + U_DN;
  constexpr int U_TOTAL = U_MODS + DEPTH * U_WL + 64 + 1;
  for (int u = bid; u < U_TOTAL; u += nb) {
    int r = u;
    if (r < U_MODS) { mods_unit(p, r / 48, r % 48, lds); continue; }
    r -= U_MODS;
    if (r < DEPTH * U_WL) {
      const int l = r / U_WL; r -= l * U_WL;
      if (r < U_IN) { wt_unit(p->w_in + (size_t)l * D * INC, D, INC, p->Win_t + (size_t)l * INC * D, r / 22, r % 22, false, lds); continue; }
      r -= U_IN;
      if (r < U_OUT) { wt_unit(p->w_out + (size_t)l * D * D, D, D, p->Wout_t + (size_t)l * D * D, r / 8, r % 8, false, lds); continue; }
      r -= U_OUT;
      if (r < U_GU) { wt_unit(p->w_gu + (size_t)l * D * 2 * FFH, D, 2 * FFH, p->Wgu_t + (size_t)l * 2 * FFH * D, r / 44, r % 44, true, lds); continue; }
      r -= U_GU;
      wt_unit(p->w_down + (size_t)l * FFH * D, FFH, D, p->Wdown_t + (size_t)l * D * FFH, r / 8, r % 8, false, lds);
      continue;
    }
    r -= DEPTH * U_WL;
    if (r < 64) {
      const int l = r >> 4, n = (r >> 2) & 3, dir = (r >> 1) & 1, kind = r & 1;
      const float* src = (kind ? p->lru_wx : p->lru_wa) + (size_t)((l * 2 + dir) * 4 + n) * 4096;
      bf16_t* dst = p->Wl + (size_t)r * 4096;
      for (int e = tid; e < 4096; e += NT) { const int j = e >> 6, i = e & 63; dst[j * 64 + i] = (bf16_t)f2bf(src[i * 64 + j]); }
      continue;
    }
    for (int e = tid; e < 128 * 16; e += NT) {
      const int pos = e >> 4, i = e & 15;
      const float inv = 1.0f / powf(10000.0f, (float)(2 * i) / 32.0f);
      const float ang = (float)pos * inv;
      p->rope[e * 2] = cosf(ang); p->rope[e * 2 + 1] = sinf(ang);
    }
  }
}

DI void phase_norm(KP p, const float* g, const float* mods_l, int shift_idx, int scale_idx, int nrows, const float* xlat, const float* xctx) {
  const int lane = tid_() & 63, gw = bid_() * 8 + (tid_() >> 6), ngw = gdim_() * 8;
  constexpr int R = 4;
#pragma unroll 1
  for (int row0 = gw; row0 < nrows; row0 += R * ngw) {
    f32x4 v[R][4]; float ss[R];
#pragma unroll
    for (int r = 0; r < R; ++r) {
      const int row = min(row0 + r * ngw, nrows - 1);
      const float* xr = row < TL ? xlat + (size_t)row * D : xctx + (size_t)(row - TL) * D;
#pragma unroll
      for (int j = 0; j < 4; ++j) v[r][j] = *(const f32x4*)(xr + j * 256 + lane * 4);
    }
    const int vsu = row0 < SEQ ? 0 : (row0 < TL ? 1 : 2);
    f32x4 wv[4], sv[4];
#pragma unroll
    for (int j = 0; j < 4; ++j) {
      const int c = j * 256 + lane * 4;
      wv[j] = *(const f32x4*)(g + c) * (*(const f32x4*)(mods_l + vsu * 6144 + scale_idx * 1024 + c) + 1.0f);
      sv[j] = *(const f32x4*)(mods_l + vsu * 6144 + shift_idx * 1024 + c);
    }
#pragma unroll
    for (int r = 0; r < R; ++r) {
      float s_ = 0.f;
#pragma unroll
      for (int j = 0; j < 4; ++j) s_ += (v[r][j].x * v[r][j].x + v[r][j].y * v[r][j].y) + (v[r][j].z * v[r][j].z + v[r][j].w * v[r][j].w);
      ss[r] = wave_sum(s_);
    }
#pragma unroll
    for (int r = 0; r < R; ++r) {
      const int row = row0 + r * ngw;
      if (row < nrows) {
        const float rstd = 1.0f / sqrtf(ss[r] * (1.0f / D) + 1e-6f);
        const int vs = row < SEQ ? 0 : (row < TL ? 1 : 2);
        bf16_t* hr = p->H + (size_t)row * D;
        if (vs == vsu) {
#pragma unroll
          for (int j = 0; j < 4; ++j) {
            const f32x4 h = v[r][j] * rstd * wv[j] + sv[j];
            u32x2 o; o.x = pk2(h.x, h.y); o.y = pk2(h.z, h.w);
            *(u32x2*)(hr + j * 256 + lane * 4) = o;
          }
        } else {
          const float* sh = mods_l + vs * 6144 + shift_idx * 1024;
          const float* sc = mods_l + vs * 6144 + scale_idx * 1024;
#pragma unroll
          for (int j = 0; j < 4; ++j) {
            const int c = j * 256 + lane * 4;
            const f32x4 gv = *(const f32x4*)(g + c), shv = *(const f32x4*)(sh + c), scv = *(const f32x4*)(sc + c);
            const f32x4 h = v[r][j] * rstd * (gv * (scv + 1.0f)) + shv;
            u32x2 o; o.x = pk2(h.x, h.y); o.y = pk2(h.z, h.w);
            *(u32x2*)(hr + c) = o;
          }
        }
      }
    }
  }
}

DI void phase_final(KP p) {
  const int lane = tid_() & 63, gw = bid_() * 8 + (tid_() >> 6), ngw = gdim_() * 8;
  constexpr int R = 4;
#pragma unroll 1
  for (int row0 = gw; row0 < TL; row0 += R * ngw) {
    f32x4 v[R][4]; float ss[R];
#pragma unroll
    for (int r = 0; r < R; ++r) {
      const int row = min(row0 + r * ngw, TL - 1);
      const float* xr = p->X + (size_t)row * D;
#pragma unroll
      for (int j = 0; j < 4; ++j) v[r][j] = *(const f32x4*)(xr + j * 256 + lane * 4);
    }
#pragma unroll
    for (int r = 0; r < R; ++r) {
      float s_ = 0.f;
#pragma unroll
      for (int j = 0; j < 4; ++j) s_ += (v[r][j].x * v[r][j].x + v[r][j].y * v[r][j].y) + (v[r][j].z * v[r][j].z + v[r][j].w * v[r][j].w);
      ss[r] = wave_sum(s_);
    }
#pragma unroll
    for (int r = 0; r < R; ++r) {
      const int row = row0 + r * ngw;
      if (row < TL) {
        const float rstd = 1.0f / sqrtf(ss[r] * (1.0f / D) + 1e-6f);
        float* orow = p->out + (size_t)row * D;
#pragma unroll
        for (int j = 0; j < 4; ++j) { const int c = j * 256 + lane * 4; const f32x4 gv = *(const f32x4*)(p->final_g + c); *(f32x4*)(orow + c) = v[r][j] * rstd * gv; }
      }
    }
  }
}

constexpr int BM = 256, BK = 64, HALF = 128, HT = HALF * BK;
DI int lds_byte(int r, int c) { const int st = (r >> 4) * 2 + (c >> 5), rr = r & 15, cc = c & 31, ob = rr * 64 + cc * 2; return st * 1024 + (ob ^ (((ob >> 9) & 1) << 5)); }
DI void stage_rc(int b, int& R, int& C) { const int st = b / 1024, sb = b % 1024, swz = sb ^ (((sb >> 9) & 1) << 5); R = (st >> 1) * 16 + swz / 64; C = (st & 1) * 32 + (swz % 64) / 2; }

struct GemmArgs { const bf16_t* A; const bf16_t* Bt; int M, N, K, mode; bf16_t* Ob; float* X; const float* gate; const float* rope; int ctx; const float* Xlat; const float* Xctx; };

DI void gemm_phase(const GemmArgs& g, char* shm_c) {
  typedef __attribute__((address_space(3))) unsigned char lds_u8;
  lds_u8* lds = (lds_u8*)shm_c;
  const int K = g.K;
  const int tid = tid_(), wid = __builtin_amdgcn_readfirstlane(tid >> 6), lane = tid & 63, wr = wid >> 2, wc = wid & 3, fr = lane & 15, fq = lane >> 4;
  unsigned voff[2];
#pragma unroll
  for (int i = 0; i < 2; ++i) { int R, C; stage_rc(tid * 16 + i * 8192, R, C); voff[i] = (unsigned)(R * K + C) * 2u; }
  const size_t kstep = (size_t)(BK * 2), hstep = (size_t)HALF * K * 2, tstep = 2 * hstep;
  const unsigned ldsw = (unsigned)wid * 1024u;
  const int aoff = lds_byte(wr * 64 + fr, fq * 8), boff = lds_byte(wc * 32 + fr, fq * 8);
#define SA(b, h) (((b) * 2 + (h)) * (HT * 2))
#define SB(b, h) ((4 + (b) * 2 + (h)) * (HT * 2))
#define STAGE(bufoff, gbase) do { _Pragma("unroll") for (int _i = 0; _i < 2; ++_i) \
    __builtin_amdgcn_global_load_lds((const unsigned*)((const char*)(gbase) + voff[_i]), (__attribute__((address_space(3))) unsigned*)(lds + (bufoff) + ldsw + _i * 8192), 16, 0, 0); } while (0)
#define LDA(dst, b, h) do { _Pragma("unroll") for (int m = 0; m < 4; ++m) _Pragma("unroll") for (int k = 0; k < 2; ++k) dst[m][k] = *(const __attribute__((address_space(3))) bf16x8*)(lds + SA(b, h) + aoff + m * 2048 + k * 1024); } while (0)
#define LDB(dst, b, h) do { _Pragma("unroll") for (int n = 0; n < 2; ++n) _Pragma("unroll") for (int k = 0; k < 2; ++k) dst[n][k] = *(const __attribute__((address_space(3))) bf16x8*)(lds + SB(b, h) + boff + n * 2048 + k * 1024); } while (0)
#define MMA(ai, bj, At_, Bt_) do { __builtin_amdgcn_s_setprio(1); \
    _Pragma("unroll") for (int m = 0; m < 4; ++m) _Pragma("unroll") for (int n = 0; n < 2; ++n) _Pragma("unroll") for (int k = 0; k < 2; ++k) \
      acc[ai][bj][m][n] = MFMA16(Bt_[n][k], At_[m][k], acc[ai][bj][m][n]); \
    __builtin_amdgcn_s_setprio(0); } while (0)
#define WAIT_V(n) asm volatile("s_waitcnt vmcnt(" #n ")" ::: "memory")
#define WAIT_L(n) asm volatile("s_waitcnt lgkmcnt(" #n ")" ::: "memory")
#define BAR __builtin_amdgcn_s_barrier()
#define SCHED __builtin_amdgcn_sched_barrier(0)
  const int nM = g.M / BM, nN = g.N / BM, ntiles = nM * nN;
  const int nt = K / BK;
#define TILE_PMPN(tile_, pm_, pn_) do { int wgid = (tile_); const int q = ntiles / 8, rr = ntiles % 8, xcd = wgid % 8, off = wgid / 8; \
    wgid = (xcd < rr ? xcd * (q + 1) : rr * (q + 1) + (xcd - rr) * q) + off; \
    const int nig = 8 * nN, gid = wgid / nig, fm = gid * 8, gsz = (nM - fm) < 8 ? (nM - fm) : 8; \
    pm_ = fm + ((wgid % nig) % gsz); pn_ = (wgid % nig) / gsz; } while (0)
#define PRO_ISSUE(cA_, cB_) do { STAGE(SB(0, 0), cB_); STAGE(SA(0, 0), cA_); STAGE(SB(0, 1), (cB_) + hstep); STAGE(SA(0, 1), (cA_) + hstep); \
    STAGE(SB(1, 0), (cB_) + kstep); STAGE(SA(1, 0), (cA_) + kstep); STAGE(SB(1, 1), (cB_) + hstep + kstep); } while (0)
  const int gstep = gdim_();
  int tile = bid_();
  int pm = 0, pn = 0;
  const char* cA = nullptr; const char* cB = nullptr;
  const bool has_work = tile < ntiles;
  f32x4 acc[2][2][4][2];
  bf16x8 At[4][2], B0[2][2], B1[2][2];
  if (has_work) {
    TILE_PMPN(tile, pm, pn); cA = (const char*)g.A + (size_t)pm * tstep; cB = (const char*)g.Bt + (size_t)pn * tstep;
#pragma unroll
    for (int a = 0; a < 2; ++a)
#pragma unroll
      for (int b = 0; b < 2; ++b)
#pragma unroll
        for (int m = 0; m < 4; ++m)
#pragma unroll
          for (int n = 0; n < 2; ++n) acc[a][b][m][n] = (f32x4){0.f, 0.f, 0.f, 0.f};
    STAGE(SB(0, 0), cB); STAGE(SB(0, 1), cB + hstep); STAGE(SA(0, 0), cA); STAGE(SA(0, 1), cA + hstep);
    if (wr == 1) BAR;
    WAIT_V(2); BAR;
    STAGE(SB(1, 0), cB + kstep); STAGE(SA(1, 0), cA + kstep); STAGE(SB(1, 1), cB + hstep + kstep);
    WAIT_V(6); BAR;
  }
#pragma unroll 1
  while (has_work) {
    const int brow = pm * BM, bcol = pn * BM;
    const int ntile = tile + gstep;
    const bool has_next = ntile < ntiles;
    int npm = pm, npn = pn;
    if (has_next) TILE_PMPN(ntile, npm, npn);
    const char* nA = (const char*)g.A + (size_t)npm * tstep; const char* nB = (const char*)g.Bt + (size_t)npn * tstep;
#pragma unroll 1
    for (int t = 0; t < nt; t += 2) {
      const bool last = t == nt - 2;
      const char* a1 = cA + (size_t)(t + 1) * kstep;
      const char* a2 = last ? nA : cA + (size_t)(t + 2) * kstep; const char* b2 = last ? nB : cB + (size_t)(t + 2) * kstep;
      const char* a3 = a2 + kstep; const char* b3 = b2 + kstep;
      LDB(B0, 0, 0); LDB(B1, 0, 1); SCHED; LDA(At, 0, 0); STAGE(SA(1, 1), a1 + hstep);
      WAIT_V(8); WAIT_L(0); BAR; MMA(0, 0, At, B0); MMA(0, 1, At, B1); BAR; SCHED;
      LDA(At, 0, 1); STAGE(SB(0, 0), b2); STAGE(SB(0, 1), b2 + hstep); STAGE(SA(0, 0), a2);
      WAIT_V(8); WAIT_L(0); BAR; MMA(1, 0, At, B0); MMA(1, 1, At, B1); BAR; SCHED;
      LDB(B0, 1, 0); LDB(B1, 1, 1); SCHED; LDA(At, 1, 0); STAGE(SA(0, 1), a2 + hstep);
      WAIT_V(8); WAIT_L(0); BAR; MMA(0, 0, At, B0); MMA(0, 1, At, B1); BAR; SCHED;
      LDA(At, 1, 1); STAGE(SB(1, 0), b3); STAGE(SB(1, 1), b3 + hstep); STAGE(SA(1, 0), a3);
      WAIT_V(8); WAIT_L(0); BAR; MMA(1, 0, At, B0); MMA(1, 1, At, B1); BAR; SCHED;
    }
    if (wr == 0) BAR;
    if (g.mode == 0) {
#pragma unroll
      for (int ai = 0; ai < 2; ++ai)
#pragma unroll
        for (int m = 0; m < 4; ++m) {
          const int row = brow + ai * HALF + wr * 64 + m * 16 + fr;
          bf16_t* rp0 = g.Ob + (size_t)row * g.N + bcol + wc * 32;
#pragma unroll
          for (int bj = 0; bj < 2; ++bj) {
            f32x4 v0 = acc[ai][bj][m][0], v1 = acc[ai][bj][m][1];
            const int gb = bcol + bj * HALF + wc * 32;
            if (g.rope != nullptr && gb >= 512 && gb < 1536 && brow < TL) {
              const int sq = row & (SEQ - 1), pos = (gb & 32) ? (sq & 63) : (sq >> 6);
              const float* rt = g.rope + (pos * 16 + 4 * fq) * 2;
              const f32x4 t0 = *(const f32x4*)rt, t1 = *(const f32x4*)(rt + 4);
              const f32x4 cs = {t0[0], t0[2], t1[0], t1[2]}, sn = {t0[1], t0[3], t1[1], t1[3]};
              const f32x4 r0 = v0 * cs - v1 * sn, r1 = v1 * cs + v0 * sn;
              v0 = r0; v1 = r1;
            }
            u32x2 a, b2; a.x = pk2(v0[0], v0[1]); a.y = pk2(v0[2], v0[3]); b2.x = pk2(v1[0], v1[1]); b2.y = pk2(v1[2], v1[3]);
            const auto sx = __builtin_amdgcn_permlane16_swap(a.x, b2.x, false, false);
            const auto sy = __builtin_amdgcn_permlane16_swap(a.y, b2.y, false, false);
            u32x4 w4; w4.x = sx[0]; w4.y = sy[0]; w4.z = sx[1]; w4.w = sy[1];
            *(u32x4*)(rp0 + bj * HALF + ((fq & 1) ? 16 + 4 * (fq - 1) : 4 * fq)) = w4;
          }
        }
    } else if (g.mode == 1) {
      const float* gp = g.gate + (brow < SEQ ? 0 : 1) * 6144 + bcol + wc * 32 + 4 * fq;
      f32x4 gvv[2][2];
#pragma unroll
      for (int bj = 0; bj < 2; ++bj)
#pragma unroll
        for (int n = 0; n < 2; ++n) gvv[bj][n] = *(const f32x4*)(gp + bj * HALF + n * 16);
#pragma unroll
      for (int ai = 0; ai < 2; ++ai)
#pragma unroll
        for (int m = 0; m < 4; ++m) {
          const int row = brow + ai * HALF + wr * 64 + m * 16 + fr;
          float* rp = g.X + (size_t)row * g.N + bcol + wc * 32 + 4 * fq;
          const float* rin = g.Xlat + (size_t)row * g.N + bcol + wc * 32 + 4 * fq;
#pragma unroll
          for (int bj = 0; bj < 2; ++bj)
#pragma unroll
            for (int n = 0; n < 2; ++n) {
              f32x4 xv = *(const f32x4*)(rin + bj * HALF + n * 16);
              xv += gvv[bj][n] * acc[ai][bj][m][n];
              *(f32x4*)(rp + bj * HALF + n * 16) = xv;
            }
        }
    } else {
      const int ldo = g.N >> 1;
#pragma unroll
      for (int ai = 0; ai < 2; ++ai)
#pragma unroll
        for (int m = 0; m < 4; ++m) {
          const int row = brow + ai * HALF + wr * 64 + m * 16 + fr;
          bf16_t* rp0 = g.Ob + (size_t)row * ldo + ((bcol + wc * 32) >> 1);
          u32x2 ob[2];
#pragma unroll
          for (int bj = 0; bj < 2; ++bj) {
            const f32x4 gg = acc[ai][bj][m][0], uu = acc[ai][bj][m][1];
            f32x4 r;
#pragma unroll
            for (int j = 0; j < 4; ++j) r[j] = gg[j] * sigmoidf_(gg[j]) * uu[j];
            ob[bj].x = pk2(r[0], r[1]); ob[bj].y = pk2(r[2], r[3]);
          }
          const auto sx = __builtin_amdgcn_permlane16_swap(ob[0].x, ob[1].x, false, false);
          const auto sy = __builtin_amdgcn_permlane16_swap(ob[0].y, ob[1].y, false, false);
          u32x4 w4; w4.x = sx[0]; w4.y = sy[0]; w4.z = sx[1]; w4.w = sy[1];
          *(u32x4*)(rp0 + ((fq & 1) ? HALF / 2 + 4 * (fq - 1) : 4 * fq)) = w4;
        }
    }
    if (!has_next) break;
#pragma unroll
    for (int a = 0; a < 2; ++a)
#pragma unroll
      for (int b = 0; b < 2; ++b)
#pragma unroll
        for (int m = 0; m < 4; ++m)
#pragma unroll
          for (int n = 0; n < 2; ++n) acc[a][b][m][n] = (f32x4){0.f, 0.f, 0.f, 0.f};
    tile = ntile; pm = npm; pn = npn; cA = nA; cB = nB;
    if (wr == 1) BAR;
  }
  if (has_work) {
    WAIT_V(0);
    BAR;
  }
  if (g.mode == 1 && g.ctx) {
    bf16_t* sAm = (bf16_t*)shm_c;
    bf16_t* sBm = sAm + 32 * 520;
#pragma unroll 1
    for (int piece = bid_(); piece < 256; piece += gstep) {
      const int rb = piece >> 4, cb = piece & 15, mt = wid >> 2, ntl = wid & 3;
      const bf16_t* Ag = g.A + (size_t)(TL + rb * 32) * K;
      const bf16_t* Bg = g.Bt + (size_t)(cb * 64) * K;
      const int prow = tid >> 6, pc = tid & 63;
      f32x4 c4 = {0.f, 0.f, 0.f, 0.f};
      u32x4 ra[4], rbv[8];
#define MLOAD(k0_) do { const int cw_ = (K - (k0_)) < 512 ? (K - (k0_)) : 512; if (pc * 8 < cw_) { \
        _Pragma("unroll") for (int u = 0; u < 4; ++u) ra[u] = *(const u32x4*)(Ag + (size_t)(prow + 8 * u) * K + (k0_) + pc * 8); \
        _Pragma("unroll") for (int u = 0; u < 8; ++u) rbv[u] = *(const u32x4*)(Bg + (size_t)(prow + 8 * u) * K + (k0_) + pc * 8); } } while (0)
      MLOAD(0);
#pragma unroll 1
      for (int k0 = 0; k0 < K; k0 += 512) {
        const int cw = (K - k0) < 512 ? (K - k0) : 512;
        __syncthreads();
        if (pc * 8 < cw) {
#pragma unroll
          for (int u = 0; u < 4; ++u) *(u32x4*)(sAm + (prow + 8 * u) * 520 + pc * 8) = ra[u];
#pragma unroll
          for (int u = 0; u < 8; ++u) *(u32x4*)(sBm + (prow + 8 * u) * 520 + pc * 8) = rbv[u];
        }
        __syncthreads();
        if (k0 + 512 < K) MLOAD(k0 + 512);
#pragma unroll 4
        for (int u = 0; u < cw / 32; ++u) {
          const bf16x8 av = *(const bf16x8*)(sAm + (mt * 16 + fr) * 520 + 32 * u + 8 * fq);
          const bf16x8 bv = *(const bf16x8*)(sBm + (ntl * 16 + fr) * 520 + 32 * u + 8 * fq);
          c4 = MFMA16(av, bv, c4);
        }
      }
#undef MLOAD
      const int col = cb * 64 + ntl * 16 + fr;
      const float gv = g.gate[2 * 6144 + col];
#pragma unroll
      for (int j = 0; j < 4; ++j) { const size_t ro = (size_t)(rb * 32 + mt * 16 + 4 * fq + j) * g.N + col; g.X[(size_t)TL * g.N + ro] = g.Xctx[ro] + gv * c4[j]; }
    }
    __syncthreads();
  }
#undef SA
#undef SB
#undef STAGE
#undef LDA
#undef LDB
#undef MMA
}

constexpr int LRU_WN = 0, LRU_CONST = 36864, LRU_CARRY = 38400, LRU_AGGW = 42496, LRU_PART = 50688, LRU_WAVE = 54784, LRU_WAVE_BYTES = 9216;

template <int MODE, int CH = -1>
DI void lru_group_unit(KP p, int l, int g, int n, char* ldsc) {
  const int tid = tid_(), lane = tid & 63, w = __builtin_amdgcn_readfirstlane(tid >> 6), fr = lane & 15, fq = lane >> 4;
  bf16_t* Wn = (bf16_t*)(ldsc + LRU_WN);
  float* cst = (float*)(ldsc + LRU_CONST);
  float* carry = (float*)(ldsc + LRU_CARRY);
  float* aggw = (float*)(ldsc + LRU_AGGW);
  float* part = (float*)(ldsc + LRU_PART);
  bf16_t* xs = (bf16_t*)(ldsc + LRU_WAVE + w * LRU_WAVE_BYTES);
  bf16_t* xcb = xs + 36 * 64;
  const bool isctx = g >= 64;
  const int b = isctx ? g - 64 : g >> 5, gi = isctx ? 0 : g & 31;
  const int L = isctx ? CTXL : SEQ;
  const int row0 = g * 256 + w * 32;
  const int t0 = gi * 256 + w * 32;
  __syncthreads();
  {
    const bf16_t* Wg = p->Wl + (size_t)((l * 4 + n) * 4) * 4096;
#pragma unroll
    for (int u = 0; u < 4; ++u) { const int q = tid + NT * u, rowi = q >> 3, pc = q & 7;
      *(u32x4*)(Wn + rowi * 72 + pc * 8) = *(const u32x4*)(Wg + rowi * 64 + pc * 8); }
    if (tid < 128) { const int dir = tid >> 6, ch = tid & 63, gch = (l * 2 + dir) * 256 + n * 64 + ch;
      cst[tid * 3 + 0] = p->lru_ba[gch]; cst[tid * 3 + 1] = p->lru_bx[gch]; cst[tid * 3 + 2] = -8.0f * log1pf(expf(-p->lru_lam[gch])); }
    for (int q = lane; q < 35 * 8; q += 64) {
      const int tt = q >> 3, pc = q & 7, t = t0 + tt - 2;
      u32x4 v = {0u, 0u, 0u, 0u};
      if (t >= 0 && t < L) v = *(const u32x4*)(p->P + (size_t)(row0 + tt - 2) * INC + n * 64 + pc * 8);
      *(u32x4*)(xs + tt * 64 + pc * 8) = v;
    }
  }
  if (MODE == 1) {
    const int seg = tid >> 7, dir = (tid >> 6) & 1, ch = tid & 63, gch = n * 64 + ch;
    const int nch = isctx ? 0 : (dir == 0 ? 1 + gi : 32 - gi);
    float ca[8], cb[8];
#pragma unroll
    for (int e8 = 0; e8 < 8; ++e8) {
      const int e = seg * 8 + e8;
      const int ee = e < nch ? e : 0;
      const int gg = ee == 0 ? 64 + b : (dir == 0 ? b * 32 + (ee - 1) : b * 32 + 32 - ee);
      const float* q = p->aggG + ((size_t)(gg * 2 + dir) * 256 + gch) * 2;
      const float a_ = q[0], b_ = q[1];
      ca[e8] = e < nch ? a_ : 1.f; cb[e8] = e < nch ? b_ : 0.f;
    }
    float A = 1.f, B = 0.f;
#pragma unroll
    for (int e8 = 0; e8 < 8; ++e8) { B = ca[e8] * B + cb[e8]; A = A * ca[e8]; }
    part[((seg * 2 + dir) * 64 + ch) * 2 + 0] = A; part[((seg * 2 + dir) * 64 + ch) * 2 + 1] = B;
  }
  __syncthreads();
  {
    const int ch = lane;
    const float* cw = p->conv_w + l * 4 * 256 + n * 64 + ch;
    const float cb_ = p->conv_b[l * 256 + n * 64 + ch];
    const float w0 = cw[0], w1 = cw[256], w2 = cw[512], w3 = cw[768];
    float x0 = bf2f(xs[ch]), x1 = bf2f(xs[64 + ch]), x2 = bf2f(xs[128 + ch]);
#pragma unroll 8
    for (int t = 0; t < 32; ++t) {
      const float x3 = bf2f(xs[(t + 3) * 64 + ch]);
      const float y = cb_ + w0 * x0 + w1 * x1 + w2 * x2 + w3 * x3;
      xcb[t * 72 + ch] = (bf16_t)f2bf(y);
      x0 = x1; x1 = x2; x2 = x3;
    }
  }
  if (MODE == 1 && tid < 128) {
    const int dir = tid >> 6, ch = tid & 63, gch = n * 64 + ch;
    float h = 0.f;
#pragma unroll
    for (int sg = 0; sg < 4; ++sg) h = part[((sg * 2 + dir) * 64 + ch) * 2] * h + part[((sg * 2 + dir) * 64 + ch) * 2 + 1];
    float sa[8], sb[8];
#pragma unroll
    for (int w2 = 0; w2 < 8; ++w2) { const float* q = p->aggS + ((size_t)((g * 8 + w2) * 2 + dir) * 256 + gch) * 2; sa[w2] = q[0]; sb[w2] = q[1]; }
#pragma unroll
    for (int i = 0; i < 8; ++i) { const int w2 = dir == 0 ? i : 7 - i; carry[(w2 * 2 + dir) * 64 + ch] = h; h = sa[w2] * h + sb[w2]; }
  }
  __syncthreads();
  bf16x8 af[2][2];
#pragma unroll
  for (int m = 0; m < 2; ++m)
#pragma unroll
    for (int ks = 0; ks < 2; ++ks) af[m][ks] = *(const bf16x8*)(xcb + (16 * m + fr) * 72 + 32 * ks + 8 * fq);
  float hf[4][2][4];
#pragma unroll
  for (int dir = 0; dir < 2; ++dir)
#pragma unroll
    for (int cg = 0; cg < 4; ++cg) {
      if (CH >= 0 && (cg >> 1) != CH) continue;
      const int ch = cg * 16 + fr;
      float gl[2][4];
      if (MODE == 1 && dir == 1) {
#pragma unroll
        for (int m = 0; m < 2; ++m)
#pragma unroll
          for (int j = 0; j < 4; ++j) gl[m][j] = bf2f(p->P[(size_t)(row0 + 16 * m + 4 * fq + j) * INC + 256 + n * 64 + ch]);
      }
      bf16x8 bfr[2][2];
#pragma unroll
      for (int kind = 0; kind < 2; ++kind)
#pragma unroll
        for (int ks = 0; ks < 2; ++ks) bfr[kind][ks] = *(const bf16x8*)(Wn + ((dir * 2 + kind) * 64 + ch) * 72 + 32 * ks + 8 * fq);
      f32x4 acc[2][2];
#pragma unroll
      for (int m = 0; m < 2; ++m)
#pragma unroll
        for (int kind = 0; kind < 2; ++kind) acc[m][kind] = (f32x4){0.f, 0.f, 0.f, 0.f};
#pragma unroll
      for (int m = 0; m < 2; ++m)
#pragma unroll
        for (int ks = 0; ks < 2; ++ks)
#pragma unroll
          for (int kind = 0; kind < 2; ++kind) acc[m][kind] = MFMA16(af[m][ks], bfr[kind][ks], acc[m][kind]);
      const float ba = cst[(dir * 64 + ch) * 3], bx = cst[(dir * 64 + ch) * 3 + 1], ls8 = cst[(dir * 64 + ch) * 3 + 2];
      float a[2][4], bb[2][4];
#pragma unroll
      for (int m = 0; m < 2; ++m)
#pragma unroll
        for (int j = 0; j < 4; ++j) {
          const int t = 16 * m + 4 * fq + j;
          const float r = sigmoidf_(acc[m][0][j] + ba), ig = sigmoidf_(acc[m][1][j] + bx);
          const float la = ls8 * r, x2 = 2.0f * la;
          a[m][j] = __expf(la);
          const float em = -x2 * (1.0f + x2 * (0.5f + x2 * (0.16666667f + x2 * (0.041666668f + x2 * 0.0083333338f))));
          bb[m][j] = __builtin_amdgcn_sqrtf(em) * (ig * bf2f(xcb[t * 72 + ch]));
        }
      float IA[2], IB[2], TA[2], TB[2];
      const int src1 = (dir == 0 ? lane - 16 : lane + 16) & 63, src2 = (dir == 0 ? lane - 32 : lane + 32) & 63;
      const bool v1 = dir == 0 ? fq >= 1 : fq <= 2, v2 = dir == 0 ? fq >= 2 : fq <= 1;
      const int lastl = dir == 0 ? fr + 48 : fr;
#pragma unroll
      for (int m = 0; m < 2; ++m) {
        float A = 1.f, B = 0.f;
#pragma unroll
        for (int jj = 0; jj < 4; ++jj) { const int j = dir == 0 ? jj : 3 - jj; B = a[m][j] * B + bb[m][j]; A = A * a[m][j]; }
        float ua = __shfl(A, src1), ub = __shfl(B, src1);
        if (v1) { B = A * ub + B; A = A * ua; }
        ua = __shfl(A, src2); ub = __shfl(B, src2);
        if (v2) { B = A * ub + B; A = A * ua; }
        IA[m] = A; IB[m] = B;
        TA[m] = __shfl(A, lastl); TB[m] = __shfl(B, lastl);
      }
      const int mf = dir == 0 ? 0 : 1, ms = 1 - mf;
      if (MODE == 0) {
        if (fq == 0) {
          const float A = TA[ms] * TA[mf], B = TA[ms] * TB[mf] + TB[ms];
          float* q = p->aggS + ((size_t)((g * 8 + w) * 2 + dir) * 256 + n * 64 + ch) * 2;
          q[0] = A; q[1] = B;
          aggw[((w * 2 + dir) * 64 + ch) * 2] = A; aggw[((w * 2 + dir) * 64 + ch) * 2 + 1] = B;
        }
      } else {
        const float c = carry[(w * 2 + dir) * 64 + ch];
#pragma unroll
        for (int mi = 0; mi < 2; ++mi) {
          const int m = mi == 0 ? mf : ms;
          const float hin = mi == 0 ? c : TA[mf] * c + TB[mf];
          float ea = __shfl(IA[m], src1), eb = __shfl(IB[m], src1);
          if (!v1) { ea = 1.f; eb = 0.f; }
          float h = ea * hin + eb;
#pragma unroll
          for (int jj = 0; jj < 4; ++jj) {
            const int j = dir == 0 ? jj : 3 - jj;
            h = a[m][j] * h + bb[m][j];
            if (dir == 0) hf[cg][m][j] = h;
            else {
              const float y = hf[cg][m][j] + h, gv = gl[m][j];
              const float u = 0.7978845608028654f * (gv + 0.044715f * gv * gv * gv);
              p->MIX[(size_t)(row0 + 16 * m + 4 * fq + j) * D + n * 64 + ch] = (bf16_t)f2bf(y * gv * sigmoidf_(2.0f * u));
            }
          }
        }
      }
    }
  if (MODE == 0) {
    __syncthreads();
    if (tid < 128 && (CH < 0 || ((tid & 63) >> 5) == CH)) {
      const int dir = tid >> 6, ch = tid & 63;
      float A = 1.f, B = 0.f;
#pragma unroll
      for (int i = 0; i < 8; ++i) { const int w2 = dir == 0 ? i : 7 - i; const float a_ = aggw[((w2 * 2 + dir) * 64 + ch) * 2], b_ = aggw[((w2 * 2 + dir) * 64 + ch) * 2 + 1]; B = a_ * B + b_; A = A * a_; }
      float* q = p->aggG + ((size_t)(g * 2 + dir) * 256 + n * 64 + ch) * 2;
      q[0] = A; q[1] = B;
    }
  }
}

DI void phase_prep(KP p, int l, char* ldsc) {
  const int tid = tid_();
  constexpr int U_TR = 264 * 3;
#pragma unroll 1
  for (int r = bid_(); r < 256; r += gdim_()) lru_group_unit<0>(p, l, r >> 2, r & 3, ldsc);
#pragma unroll 1
  for (int u = bid_() - 8; u >= 0 && u < 16; u += gdim_()) {
    if (u & 1) lru_group_unit<0, 1>(p, l, 64 + (u >> 3), (u >> 1) & 3, ldsc); else lru_group_unit<0, 0>(p, l, 64 + (u >> 3), (u >> 1) & 3, ldsc);
  }
#pragma unroll 1
  for (int r = bid_() < 8 ? bid_() : bid_() - 16; r >= 0 && r < U_TR && (bid_() < 8 || bid_() >= 24); r += gdim_() - 16) {
    {

      const int chunk = r / 3, cgp = r % 3;
      int row0, b, keypos;
      if (chunk < 256) { b = chunk >> 7; row0 = chunk * 64; keypos = CTXL + (chunk & 127) * 64; }
      else { const int cc = chunk - 256; b = cc >> 2; row0 = TL + cc * 64; keypos = (cc & 3) * 64; }
      const int colbase = cgp < 2 ? 1536 + cgp * 256 : 2560;
      bf16_t* Tt = (bf16_t*)ldsc;
      __syncthreads();
#pragma unroll
      for (int uu = 0; uu < 4; ++uu) {
        const int q = tid + NT * uu, rr = q >> 5, pc = q & 31;
        *(u32x4*)(Tt + rr * 264 + pc * 8) = *(const u32x4*)(p->P + (size_t)(row0 + rr) * INC + colbase + pc * 8);
      }
      __syncthreads();
#pragma unroll
      for (int uu = 0; uu < 4; ++uu) {
        const int q = tid + NT * uu, c = q >> 3, pk = q & 7;
        const bf16_t* s = Tt + (8 * pk) * 264 + c;
        u32x4 o;
        o.x = (unsigned)s[0] | ((unsigned)s[264] << 16); o.y = (unsigned)s[2 * 264] | ((unsigned)s[3 * 264] << 16);
        o.z = (unsigned)s[4 * 264] | ((unsigned)s[5 * 264] << 16); o.w = (unsigned)s[6 * 264] | ((unsigned)s[7 * 264] << 16);
        bf16_t* dst;
        if (cgp < 2) { const int h = cgp * 2 + (c >> 7), dv = c & 127; dst = p->Vtd + ((size_t)((b * 4 + h) * 128 + dv)) * NKEY + keypos + 8 * pk; }
        else { const int h = c >> 6, dv = c & 63; dst = p->Vtn + ((size_t)((b * 4 + h) * 64 + dv)) * NKEY + keypos + 8 * pk; }
        *(u32x4*)dst = o;
      }
    }
  }
}

constexpr float QK_C = 0.125f * 1.4426950408889634f;
constexpr float LOG2E = 1.4426950408889634f;

typedef __attribute__((address_space(3))) unsigned char lds_u8;
typedef __attribute__((address_space(3))) bf16x8 lds_bf16x8;
#define GLDS16(gp, lp) __builtin_amdgcn_global_load_lds((const unsigned*)(gp), (__attribute__((address_space(3))) unsigned*)(lp), 16, 0, 0)
template <int DV, bool LOCAL>
DI void attn_tile(const bf16x8 (&qf)[4], const lds_u8* Kb, const lds_u8* Vb, const int (&ko)[4], const int (&vo)[4], f32x16 (&o)[DV / 32], float& m, float& l, int hh,
                  const float* rpbs, int drow, int cq, int c0) {
  constexpr int ND = DV / 32;
#define ASCHED __builtin_amdgcn_sched_barrier(0)
  f32x16 st[2];
  {
    bf16x8 kf[2][4];
#pragma unroll
    for (int t = 0; t < 2; ++t)
#pragma unroll
      for (int ks = 0; ks < 4; ++ks) kf[t][ks] = *(const lds_bf16x8*)(Kb + ko[ks] + t * 4096);
    ASCHED;
#pragma unroll
    for (int t = 0; t < 2; ++t) {
      f32x16 s;
#pragma unroll
      for (int i = 0; i < 16; ++i) s[i] = 0.f;
#pragma unroll
      for (int ks = 0; ks < 4; ++ks) s = MFMA32(kf[t][ks], qf[ks], s);
      st[t] = s;
    }
  }
  bf16x8 va[2][ND];
#pragma unroll
  for (int s2 = 0; s2 < 2; ++s2)
#pragma unroll
    for (int d = 0; d < ND; ++d) va[s2][d] = *(const lds_bf16x8*)(Vb + vo[s2] + d * 4096);
  ASCHED;
  float mx = -3.0e38f;
  if (LOCAL) {
#pragma unroll
    for (int t = 0; t < 2; ++t)
#pragma unroll
      for (int i = 0; i < 16; ++i) {
        const int ck = 32 * t + 16 * (i >> 3) + 8 * hh + (i & 7);
        const int dc = ck - cq + 15;
        const bool ok = (ck >= c0) && (ck < c0 + 16);
        const int dcc = dc < 0 ? 0 : (dc > 30 ? 30 : dc);
        const float z = ok ? __builtin_fmaf(st[t][i], QK_C, rpbs[drow * 31 + dcc]) : -1.0e30f;
        st[t][i] = z; mx = fmaxf(mx, z);
      }
  } else {
#pragma unroll
    for (int t = 0; t < 2; ++t)
#pragma unroll
      for (int i = 0; i < 16; ++i) mx = fmaxf(mx, st[t][i]);
    mx *= QK_C;
  }
  mx = xhalf_max(mx);
  if (!__all(mx <= m + 8.0f)) {
    const float mn = fmaxf(m, mx);
    const float alpha = __builtin_amdgcn_exp2f(m - mn);
    m = mn; l *= alpha;
#pragma unroll
    for (int d = 0; d < ND; ++d) o[d] *= alpha;
  }
  float ps = 0.f;
#pragma unroll
  for (int t = 0; t < 2; ++t)
#pragma unroll
    for (int i = 0; i < 16; ++i) {
      const float pv = LOCAL ? __builtin_amdgcn_exp2f(st[t][i] - m) : __builtin_amdgcn_exp2f(__builtin_fmaf(st[t][i], QK_C, -m));
      st[t][i] = pv; ps += pv;
    }
  l += ps;
  ASCHED;
  bf16x8 vb[2][ND];
#pragma unroll
  for (int s2 = 0; s2 < 2; ++s2)
#pragma unroll
    for (int d = 0; d < ND; ++d) vb[s2][d] = *(const lds_bf16x8*)(Vb + vo[2 + s2] + d * 4096);
#pragma unroll
  for (int s2 = 0; s2 < 2; ++s2) {
    u32x4 pw;
    pw.x = pk2(st[0][8 * s2 + 0], st[0][8 * s2 + 1]); pw.y = pk2(st[0][8 * s2 + 2], st[0][8 * s2 + 3]);
    pw.z = pk2(st[0][8 * s2 + 4], st[0][8 * s2 + 5]); pw.w = pk2(st[0][8 * s2 + 6], st[0][8 * s2 + 7]);
    const bf16x8 pf = __builtin_bit_cast(bf16x8, pw);
#pragma unroll
    for (int d = 0; d < ND; ++d) o[d] = MFMA32(va[s2][d], pf, o[d]);
  }
  ASCHED;
#pragma unroll
  for (int s2 = 0; s2 < 2; ++s2) {
    u32x4 pw;
    pw.x = pk2(st[1][8 * s2 + 0], st[1][8 * s2 + 1]); pw.y = pk2(st[1][8 * s2 + 2], st[1][8 * s2 + 3]);
    pw.z = pk2(st[1][8 * s2 + 4], st[1][8 * s2 + 5]); pw.w = pk2(st[1][8 * s2 + 6], st[1][8 * s2 + 7]);
    const bf16x8 pf = __builtin_bit_cast(bf16x8, pw);
#pragma unroll
    for (int d = 0; d < ND; ++d) o[d] = MFMA32(vb[s2][d], pf, o[d]);
  }
#undef ASCHED
}

DI void qk_tile(const bf16x8 (&qf)[4], const lds_u8* Kb, const int (&ko)[4], f32x16 (&st)[2]) {
  bf16x8 kf[2][4];
#pragma unroll
  for (int t = 0; t < 2; ++t)
#pragma unroll
    for (int ks = 0; ks < 4; ++ks) kf[t][ks] = *(const lds_bf16x8*)(Kb + ko[ks] + t * 4096);
#pragma unroll
  for (int t = 0; t < 2; ++t) {
    f32x16 s;
#pragma unroll
    for (int i = 0; i < 16; ++i) s[i] = 0.f;
#pragma unroll
    for (int ks = 0; ks < 4; ++ks) s = MFMA32(kf[t][ks], qf[ks], s);
    st[t] = s;
  }
}
DI void pv_grp(f32x16 (&o)[4], const bf16x8 (&v)[4], const bf16x8& Pq) {
#pragma unroll
  for (int d = 0; d < 4; ++d) o[d] = MFMA32(v[d], Pq, o[d]);
}
template <int Q>
DI float exp_pack1(const f32x16 (&st)[2], float m, bf16x8& Pq) {
  float e[8]; float ps = 0.f;
#pragma unroll
  for (int j = 0; j < 8; ++j) { e[j] = __builtin_amdgcn_exp2f(__builtin_fmaf(st[Q >> 1][8 * (Q & 1) + j], QK_C, -m)); ps += e[j]; }
  u32x4 pw; pw.x = pk2(e[0], e[1]); pw.y = pk2(e[2], e[3]); pw.z = pk2(e[4], e[5]); pw.w = pk2(e[6], e[7]);
  Pq = __builtin_bit_cast(bf16x8, pw);
  return ps;
}
DI float exp_pack(const f32x16 (&st)[2], float m, bf16x8 (&Pn)[4]) {
  return (exp_pack1<0>(st, m, Pn[0]) + exp_pack1<1>(st, m, Pn[1])) + (exp_pack1<2>(st, m, Pn[2]) + exp_pack1<3>(st, m, Pn[3]));
}
DI float tile_max(const f32x16 (&st)[2]) {
  float mx = st[0][0];
#pragma unroll
  for (int t = 0; t < 2; ++t)
#pragma unroll
    for (int i = 0; i < 16; ++i) mx = fmaxf(mx, st[t][i]);
  mx *= QK_C;
  return xhalf_max(mx);
}

DI void diff_unit(KP p, int l, int b, int h, int qb, int isctx, float lamv, float lam_init, char* ldsc) {
  const int tid = tid_(), lane = tid & 63, w = __builtin_amdgcn_readfirstlane(tid >> 6), r = lane & 31, hh = lane >> 5;
  const int pr = (r & ~12) | ((r & 4) << 1) | ((r & 8) >> 1);
  const int comp = w & 1, grp = w >> 1;
  const int qrow = (isctx ? TL + b * CTXL : b * SEQ) + qb * 128 + grp * 32 + r;
  const int nt = isctx ? 4 : 132;
  lds_u8* L = (lds_u8*)ldsc;
  constexpr int STG = 32768;
  int ko[4], vo[4];
#pragma unroll
  for (int ks = 0; ks < 4; ++ks) ko[ks] = pr * 128 + (((2 * ks + hh) ^ ((pr >> 1) & 7)) << 4);
#pragma unroll
  for (int q = 0; q < 4; ++q) vo[q] = r * 128 + (((2 * q + hh) ^ ((r >> 1) & 7)) << 4);
  bf16x8 qf[4];
#pragma unroll
  for (int ks = 0; ks < 4; ++ks) qf[ks] = *(const bf16x8*)(p->P + (size_t)qrow * INC + 512 + h * 128 + comp * 64 + 16 * ks + 8 * hh);
  f32x16 o[4];
#pragma unroll
  for (int d = 0; d < 4; ++d)
#pragma unroll
    for (int i = 0; i < 16; ++i) o[d][i] = 0.f;
  float m, lsum;
  const bf16_t* vt = p->Vtd + (size_t)((b * 4 + h) * 128) * NKEY;
  const bf16_t* Pk = p->P + 1024 + h * 128;
  const int row8 = 8 * w + (lane >> 3), swz = ((lane & 7) ^ ((row8 >> 1) & 7)) << 4;
  const unsigned kq = (unsigned)(row8 * (INC * 2) + swz), vq = (unsigned)(row8 * (NKEY * 2) + swz);
#define DISSUE(kt, stg) do { const int krow_ = (kt) < 4 ? TL + b * CTXL + (kt) * 64 : b * SEQ + ((kt) - 4) * 64; \
    const char* kb_ = (const char*)(Pk + (size_t)krow_ * INC) + kq; const char* vb_ = (const char*)(vt + (kt) * 64) + vq; \
    lds_u8* sb_ = L + (stg) * STG + w * 1024; \
    GLDS16(kb_, sb_); GLDS16(kb_ + 128, sb_ + 8192); GLDS16(vb_, sb_ + 16384); GLDS16(vb_ + (size_t)64 * NKEY * 2, sb_ + 24576); } while (0)
#define VLOAD(dst, sbv, q) do { _Pragma("unroll") for (int d_ = 0; d_ < 4; ++d_) dst[d_] = *(const lds_bf16x8*)((sbv) + vo[q] + d_ * 4096); } while (0)
  asm volatile("s_waitcnt vmcnt(0)" ::: "memory");
  __syncthreads();
  DISSUE(0, 0);
  DISSUE(1, 1);
  asm volatile("s_waitcnt vmcnt(4)" ::: "memory");
  __builtin_amdgcn_s_barrier();
  bf16x8 P[4];
  {
    f32x16 st[2];
    qk_tile(qf, L + comp * 8192, ko, st);
    m = tile_max(st);
    lsum = exp_pack(st, m, P);
  }
  int stg = 0;
  bool need = false; float alpha = 1.f;
  if (w >= 4) __builtin_amdgcn_s_setprio(1);
  bf16x8 vA[4], vB[4];
  VLOAD(vA, L + 16384, 0); VLOAD(vB, L + 16384, 1);
#define FENCE __builtin_amdgcn_sched_barrier(0)
#pragma unroll 1
  for (int kt = 0; kt < nt - 1; ++kt) {
    asm volatile("s_waitcnt vmcnt(0)" ::: "memory");
    __builtin_amdgcn_s_barrier();
    const int stg1 = stg == 2 ? 0 : stg + 1;
    if (kt + 2 < nt) { const int s2_ = stg >= 1 ? stg - 1 : 2; DISSUE(kt + 2, s2_); }
    if (need) {
#pragma unroll
      for (int d = 0; d < 4; ++d) o[d] *= alpha;
    }
    const lds_u8* sbv = L + stg * STG + 16384;
    const lds_u8* sbk = L + stg1 * STG + comp * 8192;
    bf16x8 kf[2][4];
    f32x16 st[2];
#pragma unroll
    for (int t = 0; t < 2; ++t)
#pragma unroll
      for (int ks = 0; ks < 4; ++ks) kf[t][ks] = *(const lds_bf16x8*)(sbk + ko[ks] + t * 4096);
    FENCE;
    pv_grp(o, vA, P[0]); pv_grp(o, vB, P[1]);
    VLOAD(vA, sbv, 2); VLOAD(vB, sbv, 3);
    FENCE;
#pragma unroll
    for (int i = 0; i < 16; ++i) { st[0][i] = 0.f; st[1][i] = 0.f; }
#pragma unroll
    for (int ks = 0; ks < 4; ++ks) st[0] = MFMA32(kf[0][ks], qf[ks], st[0]);
#pragma unroll
    for (int ks = 0; ks < 4; ++ks) st[1] = MFMA32(kf[1][ks], qf[ks], st[1]);
    FENCE;
    pv_grp(o, vA, P[2]);
    const float mx = tile_max(st);
    need = !__all(mx <= m + 8.0f);
    const float mn = need ? fmaxf(m, mx) : m;
    alpha = __builtin_amdgcn_exp2f(m - mn);
    FENCE;
    float ps = exp_pack1<0>(st, mn, P[0]);
    ps += exp_pack1<1>(st, mn, P[1]);
    ps += exp_pack1<2>(st, mn, P[2]);
    pv_grp(o, vB, P[3]);
    ps += exp_pack1<3>(st, mn, P[3]);
#pragma unroll
    for (int q = 0; q < 4; ++q) { __builtin_amdgcn_sched_group_barrier(0x402, 18, 0); __builtin_amdgcn_sched_group_barrier(0x008, 1, 0); }
    lsum = lsum * alpha + ps; m = mn;
    FENCE;
    { const lds_u8* sbn = L + stg1 * STG + 16384; VLOAD(vA, sbn, 0); VLOAD(vB, sbn, 1); }
    stg = stg1;
  }
  __builtin_amdgcn_s_setprio(0);
  if (need) {
#pragma unroll
    for (int d = 0; d < 4; ++d) o[d] *= alpha;
  }
  {
    const lds_u8* sbv = L + stg * STG + 16384;
    pv_grp(o, vA, P[0]); pv_grp(o, vB, P[1]);
    VLOAD(vA, sbv, 2); VLOAD(vB, sbv, 3);
    pv_grp(o, vA, P[2]);
    pv_grp(o, vB, P[3]);
  }
#undef FENCE
#undef DISSUE
#undef VLOAD
  __syncthreads();
  const float ltot = lsum + __shfl_xor(lsum, 32);
  const float inv = 1.0f / ltot;
  float* Ob = (float*)ldsc + grp * 4096 + lane;
  if (comp == 1) {
#pragma unroll
    for (int d = 0; d < 4; ++d)
#pragma unroll
      for (int i = 0; i < 16; ++i) Ob[(d * 16 + i) * 64] = o[d][i] * inv;
  }
  __syncthreads();
  if (comp == 0) {
    float ss = 0.f;
#pragma unroll
    for (int d = 0; d < 4; ++d)
#pragma unroll
      for (int i = 0; i < 16; ++i) { const float v = o[d][i] * inv - lamv * Ob[(d * 16 + i) * 64]; o[d][i] = v; ss += v * v; }
    ss += __shfl_xor(ss, 32);
    const float sc = (1.0f - lam_init) / sqrtf(ss * (1.0f / 128.0f) + 1e-6f);
    const float* sg = p->subln_g + l * 128;
    bf16_t* mrow = p->MIX + (size_t)qrow * D + 256 + h * 128;
#pragma unroll
    for (int d = 0; d < 4; ++d)
#pragma unroll
      for (int i4 = 0; i4 < 4; ++i4) {
        const int dv = 32 * d + 8 * i4 + 4 * hh;
        const f32x4 gv = *(const f32x4*)(sg + dv);
        u32x2 ov; ov.x = pk2(o[d][4 * i4 + 0] * sc * gv[0], o[d][4 * i4 + 1] * sc * gv[1]); ov.y = pk2(o[d][4 * i4 + 2] * sc * gv[2], o[d][4 * i4 + 3] * sc * gv[3]);
        *(u32x2*)(mrow + dv) = ov;
      }
  }
}

DI void na_unit(KP p, int l, int b, int h, int rb, int isctx, char* ldsc) {
  const int tid = tid_(), lane = tid & 63, w = __builtin_amdgcn_readfirstlane(tid >> 6), r = lane & 31, hh = lane >> 5;
  const int pr = (r & ~12) | ((r & 4) << 1) | ((r & 8) >> 1);
  const int rq0 = rb * 4, rq = rq0 + (w >> 1), cq = (w & 1) * 32 + r;
  const int qrow = isctx ? TL + b * CTXL + w * 32 + r : b * SEQ + rq * 64 + cq;
  const int r0w = min(max(rq - 4, 0), 120);
  const int c0 = min(max(cq - 8, 0), 48);
  const int rlo = min(max(rq0 - 4, 0), 120), rhi = min(max(rq0 + 3 - 4, 0), 120) + 7;
  const int nt = isctx ? 4 : 4 + (rhi - rlo + 1);
  lds_u8* L = (lds_u8*)ldsc;
  float* rpbs = (float*)(ldsc + LDS_CONST + 64);
  constexpr int STG = 16384;
  int ko[4], vo[4];
#pragma unroll
  for (int ks = 0; ks < 4; ++ks) ko[ks] = pr * 128 + (((2 * ks + hh) ^ ((pr >> 1) & 7)) << 4);
#pragma unroll
  for (int q = 0; q < 4; ++q) vo[q] = r * 128 + (((2 * q + hh) ^ ((r >> 1) & 7)) << 4);
  asm volatile("s_waitcnt vmcnt(0)" ::: "memory");
  __syncthreads();
  if (!isctx) for (int e = tid; e < 465; e += NT) rpbs[e] = p->rpb[(size_t)(l * 4 + h) * 465 + e] * LOG2E;
  bf16x8 qf[4];
#pragma unroll
  for (int ks = 0; ks < 4; ++ks) qf[ks] = *(const bf16x8*)(p->P + (size_t)qrow * INC + 2048 + h * 64 + 16 * ks + 8 * hh);
  f32x16 o[2];
#pragma unroll
  for (int d = 0; d < 2; ++d)
#pragma unroll
    for (int i = 0; i < 16; ++i) o[d][i] = 0.f;
  float m = -3.0e38f, lsum = 0.f;
  const bf16_t* vt = p->Vtn + (size_t)((b * 4 + h) * 64) * NKEY;
  const bf16_t* Pk = p->P + 2304 + h * 64;
  const int row8 = 8 * w + (lane >> 3), swz = ((lane & 7) ^ ((row8 >> 1) & 7)) << 4;
  const unsigned kq = (unsigned)(row8 * (INC * 2) + swz), vq = (unsigned)(row8 * (NKEY * 2) + swz);
#define NISSUE(kt, stg) do { const int kr_ = (kt) < 4 ? TL + b * CTXL + (kt) * 64 : b * SEQ + (rlo + (kt) - 4) * 64; const int kp_ = (kt) < 4 ? (kt) * 64 : CTXL + (rlo + (kt) - 4) * 64; \
    lds_u8* sb_ = L + (stg) * STG + w * 1024; \
    GLDS16((const char*)(Pk + (size_t)kr_ * INC) + kq, sb_); GLDS16((const char*)(vt + kp_) + vq, sb_ + 8192); } while (0)
  asm volatile("s_waitcnt vmcnt(0)" ::: "memory");
  NISSUE(0, 0);
  NISSUE(1, 1);
  int stg = 0;
#pragma unroll 1
  for (int kt = 0; kt < nt; ++kt) {
    if (kt + 1 < nt) asm volatile("s_waitcnt vmcnt(2)" ::: "memory"); else asm volatile("s_waitcnt vmcnt(0)" ::: "memory");
    asm volatile("s_waitcnt lgkmcnt(0)" ::: "memory");
    __builtin_amdgcn_s_barrier();
    if (kt + 2 < nt) { const int s2_ = stg >= 1 ? stg - 1 : 2; NISSUE(kt + 2, s2_); }
    const lds_u8* sb = L + stg * STG;
    if (kt < 4) attn_tile<64, false>(qf, sb, sb + 8192, ko, vo, o, m, lsum, hh, nullptr, 0, 0, 0);
    else {
      const int rk = rlo + kt - 4;
      if (rk >= r0w && rk < r0w + 8) attn_tile<64, true>(qf, sb, sb + 8192, ko, vo, o, m, lsum, hh, rpbs, rk - rq + 7, cq, c0);
    }
    stg = stg == 2 ? 0 : stg + 1;
  }
#undef NISSUE
  const float ltot = lsum + __shfl_xor(lsum, 32);
  const float inv = 1.0f / ltot;
  bf16_t* mrow = p->MIX + (size_t)qrow * D + 768 + h * 64;
#pragma unroll
  for (int d = 0; d < 2; ++d)
#pragma unroll
    for (int i4 = 0; i4 < 4; ++i4) {
      const int dv = 32 * d + 8 * i4 + 4 * hh;
      u32x2 ov; ov.x = pk2(o[d][4 * i4 + 0] * inv, o[d][4 * i4 + 1] * inv); ov.y = pk2(o[d][4 * i4 + 2] * inv, o[d][4 * i4 + 3] * inv);
      *(u32x2*)(mrow + dv) = ov;
    }
}

DI void phase_attn(KP p, int l, char* ldsc) {
  const bool last = l == DEPTH - 1;
  const float lam_init = 0.8f - 0.6f * expf(-0.3f * (float)l);
  float* cst = (float*)(ldsc + LDS_CONST);
  __syncthreads();
  if (tid_() < 64) {
    const float* dl = p->diff_lam + l * 256;
    const int i = tid_();
    const float s1 = wave_sum(dl[i] * dl[64 + i]), s2 = wave_sum(dl[128 + i] * dl[192 + i]);
    if (i == 0) cst[0] = expf(s1) - expf(s2) + lam_init;
  }
  __syncthreads();
  const float lamv = cst[0];
  const int nb = gdim_(), bid = bid_();
#pragma unroll 1
  for (int r = bid; r < 512; r += nb) diff_unit(p, l, r >> 8, (r >> 6) & 3, r & 63, 0, lamv, lam_init, ldsc);
#if PROBE_DUP == 6
#pragma unroll 1
  for (int r = bid; r < 512; r += nb) diff_unit(p, l, r >> 8, (r >> 6) & 3, r & 63, 0, lamv, lam_init, ldsc);
#endif
#pragma unroll 1
  for (int r = bid; r < 256; r += nb) na_unit(p, l, r >> 7, (r >> 5) & 3, r & 31, 0, ldsc);
#pragma unroll 1
  for (int r = bid; r < 256; r += nb) lru_group_unit<1>(p, l, r >> 2, r & 3, ldsc);
  if (!last) {
#pragma unroll 1
    for (int u = bid; u < 16; u += nb) { if (u & 1) lru_group_unit<1, 1>(p, l, 64 + (u >> 3), (u >> 1) & 3, ldsc); else lru_group_unit<1, 0>(p, l, 64 + (u >> 3), (u >> 1) & 3, ldsc); }
  }
#if PROBE_DUP == 4
#pragma unroll 1
  for (int r = bid; r < (last ? 64 : 66) * 4; r += nb) lru_group_unit<1>(p, l, r >> 2, r & 3, ldsc);
#endif
#if PROBE_DUP == 5
#pragma unroll 1
  for (int r = bid; r < 256; r += nb) na_unit(p, l, r >> 7, (r >> 5) & 3, r & 31, 0, ldsc);
#endif
  if (!last) {
#pragma unroll 1
    for (int r = nb - 1 - bid; r < 16; r += nb) diff_unit(p, l, r >> 3, (r >> 1) & 3, r & 1, 1, lamv, lam_init, ldsc);
#pragma unroll 1
    for (int r = nb - 17 - bid; r >= 0 && r < 8; r += nb) na_unit(p, l, r >> 2, r & 3, 0, 1, ldsc);
  }
}

__global__ void __launch_bounds__(512) mega(Params pv) {
  extern __shared__ __attribute__((aligned(16))) char lds[];
  cg::grid_group grid = cg::this_grid();
  volatile LAS unsigned* xst = (volatile LAS unsigned*)((LAS char*)lds + 131072);
  if (threadIdx.x == 0) { xst[0] = 0u; xst[1] = 0u; xst[2] = 0u; xst[3] = 0u; }
  __syncthreads();
  (void)xcd_barrier_post(get_params()->bar, xst);
#define XBAR() do { XcdBarrier xb_; xb_.bar = get_params()->bar; xb_.x = xb_xcc_id(); xb_.st = (volatile LAS unsigned*)((LAS char*)lds + 131072); xcd_barrier(xb_); } while (0)
  phase_prologue(get_params(), lds);
  if (gridDim.x == 0x7fffffffu) grid.sync();
  XBAR();
#pragma unroll 1
  for (int l = 0; l < DEPTH; ++l) {
    const bool last = l == DEPTH - 1;
    const int Mr = last ? TL : T;
    { KP p = get_params(); phase_norm(p, p->norm1_g + l * D, p->mods + (size_t)l * 3 * 6144, 0, 1, T, l ? p->X : p->x, l ? p->X + (size_t)TL * D : p->ctx); }
    XBAR();
#if PROBE_DUP == 2
    { KP p = get_params(); GemmArgs g; g.A = p->H; g.Bt = p->Win_t + (size_t)l * INC * D; g.M = T; g.N = INC; g.K = D; g.ctx = 0; g.mode = 0; g.Ob = p->P; g.X = nullptr; g.gate = nullptr; g.rope = p->rope; g.Xlat = nullptr; g.Xctx = nullptr; gemm_phase(g, lds); }
    XBAR();
#endif
    { KP p = get_params(); GemmArgs g; g.A = p->H; g.Bt = p->Win_t + (size_t)l * INC * D; g.M = T; g.N = INC; g.K = D; g.ctx = 0; g.mode = 0; g.Ob = p->P; g.X = nullptr; g.gate = nullptr; g.rope = p->rope; g.Xlat = nullptr; g.Xctx = nullptr; gemm_phase(g, lds); }
    XBAR();
    phase_prep(get_params(), l, lds);
    XBAR();
    phase_attn(get_params(), l, lds);
    XBAR();
#if PROBE_DUP == 1
    phase_attn(get_params(), l, lds);
    XBAR();
#endif
#if PROBE_DUP == 2
    { KP p = get_params(); GemmArgs g; g.A = p->MIX; g.Bt = p->Wout_t + (size_t)l * D * D; g.M = Mr; g.N = D; g.K = D; g.ctx = 0; g.mode = 0; g.Ob = p->P; g.X = nullptr; g.gate = nullptr; g.rope = nullptr; g.Xlat = nullptr; g.Xctx = nullptr; gemm_phase(g, lds); }
    XBAR();
#endif
    { KP p = get_params(); GemmArgs g; g.A = p->MIX; g.Bt = p->Wout_t + (size_t)l * D * D; g.M = TL; g.ctx = !last; g.N = D; g.K = D; g.mode = 1; g.Ob = nullptr; g.X = p->X; g.gate = p->mods + (size_t)l * 3 * 6144 + 2 * 1024; g.rope = nullptr; g.Xlat = l ? p->X : p->x; g.Xctx = l ? p->X + (size_t)TL * D : p->ctx; gemm_phase(g, lds); }
    XBAR();
    { KP p = get_params(); phase_norm(p, p->norm2_g + l * D, p->mods + (size_t)l * 3 * 6144, 3, 4, Mr, p->X, p->X + (size_t)TL * D); }
    XBAR();
#if PROBE_DUP == 2
    { KP p = get_params(); GemmArgs g; g.A = p->H; g.Bt = p->Wgu_t + (size_t)l * 2 * FFH * D; g.M = Mr; g.N = 2 * FFH; g.K = D; g.ctx = 0; g.mode = 2; g.Ob = p->P; g.X = nullptr; g.gate = nullptr; g.rope = nullptr; g.Xlat = nullptr; g.Xctx = nullptr; gemm_phase(g, lds); }
    XBAR();
#endif
    { KP p = get_params(); GemmArgs g; g.A = p->H; g.Bt = p->Wgu_t + (size_t)l * 2 * FFH * D; g.M = Mr; g.N = 2 * FFH; g.K = D; g.ctx = 0; g.mode = 2; g.Ob = p->P; g.X = nullptr; g.gate = nullptr; g.rope = nullptr; g.Xlat = nullptr; g.Xctx = nullptr; gemm_phase(g, lds); }
    XBAR();
#if PROBE_DUP == 2
    { KP p = get_params(); GemmArgs g; g.A = p->P; g.Bt = p->Wdown_t + (size_t)l * D * FFH; g.M = Mr; g.N = D; g.K = FFH; g.ctx = 0; g.mode = 0; g.Ob = p->MIX; g.X = nullptr; g.gate = nullptr; g.rope = nullptr; g.Xlat = nullptr; g.Xctx = nullptr; gemm_phase(g, lds); }
    XBAR();
#endif
    { KP p = get_params(); GemmArgs g; g.A = p->P; g.Bt = p->Wdown_t + (size_t)l * D * FFH; g.M = TL; g.ctx = !last; g.N = D; g.K = FFH; g.mode = 1; g.Ob = nullptr; g.X = p->X; g.gate = p->mods + (size_t)l * 3 * 6144 + 5 * 1024; g.rope = nullptr; g.Xlat = p->X; g.Xctx = p->X + (size_t)TL * D; gemm_phase(g, lds); }
    XBAR();
  }
  phase_final(get_params());
}

extern "C" void kernel_launch(void* const* d_in, const int* in_sizes, int n_in, void* d_out, int out_size, void* d_ws, size_t ws_size, hipStream_t stream) {
  static int grid_blocks = 0;
  if (!grid_blocks) {
    int dev = 0, cus = 0, per_cu = 0;
    hipGetDevice(&dev);
    hipDeviceGetAttribute(&cus, hipDeviceAttributeMultiprocessorCount, dev);
    hipFuncSetAttribute((const void*)mega, hipFuncAttributeMaxDynamicSharedMemorySize, LDS_BYTES);
    hipOccupancyMaxActiveBlocksPerMultiprocessor(&per_cu, (const void*)mega, NT, LDS_BYTES);
    if (per_cu < 1) per_cu = 1;
    grid_blocks = cus * per_cu;
  }
  Params p{};
  const float* const* in = (const float* const*)d_in;
  p.x = in[0]; p.c = in[1]; p.ctx = in[2]; p.c_ctx = in[3]; p.w_mod = in[4]; p.b_mod = in[5]; p.norm1_g = in[6]; p.norm2_g = in[7]; p.w_in = in[8];
  p.conv_w = in[9]; p.conv_b = in[10]; p.lru_wa = in[11]; p.lru_ba = in[12]; p.lru_wx = in[13]; p.lru_bx = in[14]; p.lru_lam = in[15]; p.diff_lam = in[16];
  p.subln_g = in[17]; p.rpb = in[18]; p.w_out = in[19]; p.w_gu = in[20]; p.w_down = in[21]; p.final_g = in[22];
  p.out = (float*)d_out;
  char* ws = (char*)d_ws; size_t off = 0;
  auto take = [&](size_t bytes) { char* q = ws + off; off += (bytes + 255) & ~(size_t)255; return q; };
  p.Win_t = (bf16_t*)take((size_t)DEPTH * INC * D * 2);
  p.Wout_t = (bf16_t*)take((size_t)DEPTH * D * D * 2);
  p.Wgu_t = (bf16_t*)take((size_t)DEPTH * 2 * FFH * D * 2);
  p.Wdown_t = (bf16_t*)take((size_t)DEPTH * D * FFH * 2);
  p.Wl = (bf16_t*)take((size_t)64 * 4096 * 2);
  p.X = (float*)take((size_t)T * D * 4);
  p.H = (bf16_t*)take((size_t)T * D * 2);
  p.P = (bf16_t*)take((size_t)T * INC * 2);
  p.MIX = (bf16_t*)take((size_t)T * D * 2);
  p.Vtd = (bf16_t*)take((size_t)NBATCH * 4 * 128 * NKEY * 2);
  p.Vtn = (bf16_t*)take((size_t)NBATCH * 4 * 64 * NKEY * 2);
  p.mods = (float*)take((size_t)DEPTH * 3 * 6144 * 4);
  p.rope = (float*)take((size_t)128 * 16 * 2 * 4);
  p.aggS = (float*)take((size_t)66 * 8 * 2 * 256 * 2 * 4);
  p.aggG = (float*)take((size_t)66 * 2 * 256 * 2 * 4);
  p.bar = (unsigned*)take((size_t)XCD_BAR_WORDS * 4);
  if (off > ws_size) { fprintf(stderr, "kernel_launch: workspace too small: need %zu have %zu\n", off, ws_size); return; }
  if (hipMemsetAsync(p.bar, 0, (size_t)XCD_BAR_WORDS * 4, stream) != hipSuccess) { fprintf(stderr, "kernel_launch: memset of barrier words failed\n"); return; }
  void* args[] = {&p};
  hipError_t e = hipLaunchCooperativeKernel((void*)mega, dim3(grid_blocks), dim3(NT), args, LDS_BYTES, stream);
  if (e != hipSuccess) fprintf(stderr, "cooperative launch failed: %s (grid %d)\n", hipGetErrorString(e), grid_blocks);
}
```
